# Optimizing an MI355X kernel written in HIP

```python
import math
import jax, jax.numpy as jnp
from jax import lax
import numpy as np

D_MODEL = 2048
BATCH = 8
SEQ = 2048
DEPTH = 1

N_DIFF_HEADS = 8
DIFF_HEAD_DIM = 64
DIFF_V_DIM = 2 * DIFF_HEAD_DIM
DIFF_WIDTH = N_DIFF_HEADS * DIFF_V_DIM
N_RET_HEADS = 8
RET_QK_DIM = 64
RET_V_DIM = 128
RET_WIDTH = N_RET_HEADS * RET_V_DIM
MIX_WIDTH = DIFF_WIDTH + RET_WIDTH
COL_SPLITS = (
    N_DIFF_HEADS * 2 * DIFF_HEAD_DIM,
    N_DIFF_HEADS * 2 * DIFF_HEAD_DIM,
    DIFF_WIDTH,
    N_RET_HEADS * RET_QK_DIM,
    N_RET_HEADS * RET_QK_DIM,
    RET_WIDTH,
    RET_WIDTH,
)
IN_COLS = sum(COL_SPLITS)
Q_BLOCK = 128
RET_CHUNK = 128
ROPE_BASE = 10000.0
N_BUCKETS = 32
MAX_DISTANCE = 128
N_GROUPS = 4
EXPERTS_PER_GROUP = 8
N_EXPERTS = N_GROUPS * EXPERTS_PER_GROUP
TOP_K_INNER = 2
D_FF_EXPERT = 1024
EPS = 1e-6

kernel_name = "hymba_diffattn_retnet_hmoe_block"


def rms_norm(x, g):
    xf = x.astype(jnp.float32)
    y = xf * lax.rsqrt(jnp.mean(xf * xf, axis=-1, keepdims=True) + EPS)
    return (y * g.astype(jnp.float32)).astype(x.dtype)


def t5_bucket(dist):
    max_exact = N_BUCKETS // 2
    d = jnp.maximum(dist, 0)
    log_ratio = jnp.log(jnp.maximum(d, 1).astype(jnp.float32) / max_exact) / math.log(MAX_DISTANCE / max_exact)
    large = max_exact + (log_ratio * (N_BUCKETS - max_exact)).astype(jnp.int32)
    large = jnp.minimum(large, N_BUCKETS - 1)
    return jnp.where(d < max_exact, d, large)


def rotary(x, pos):
    d = x.shape[-1]
    inv_freq = ROPE_BASE ** (-jnp.arange(0, d, 2, dtype=jnp.float32) / d)
    ang = pos.astype(jnp.float32)[:, None] * inv_freq[None, :]
    cos = jnp.cos(ang)[None, :, None, :].astype(x.dtype)
    sin = jnp.sin(ang)[None, :, None, :].astype(x.dtype)
    x1, x2 = x[..., : d // 2], x[..., d // 2:]
    return jnp.concatenate([x1 * cos - x2 * sin, x1 * sin + x2 * cos], axis=-1)


def diff_attention(q, k, v, rel_bias, lam):
    S = q.shape[1]
    scale = DIFF_HEAD_DIM ** -0.5
    outs = []
    for blk in range(S // Q_BLOCK):
        s0, s1 = blk * Q_BLOCK, (blk + 1) * Q_BLOCK
        qb = q[:, s0:s1]
        kb, vb = k[:, :s1], v[:, :s1]
        logits = jnp.einsum('bqhcd,bkhcd->bhcqk', qb, kb).astype(jnp.float32) * scale
        dist = jnp.arange(s0, s1)[:, None] - jnp.arange(s1)[None, :]
        bias = jnp.transpose(rel_bias[t5_bucket(dist)], (2, 0, 1)).astype(jnp.float32)
        logits = logits + bias[None, :, None]
        logits = jnp.where((dist >= 0)[None, None, None], logits, -jnp.inf)
        p = jax.nn.softmax(logits, axis=-1)
        attn = (p[:, :, 0] - lam * p[:, :, 1]).astype(v.dtype)
        outs.append(jnp.einsum('bhqk,bkhd->bqhd', attn, vb))
    return jnp.concatenate(outs, axis=1)


def retention(q, k, v):
    B, S, H, dk = q.shape
    dv = v.shape[-1]
    C = RET_CHUNK
    NC = S // C
    log_g = jnp.log(1.0 - jnp.exp2(-5.0 - jnp.arange(H, dtype=jnp.float32)))
    n = jnp.arange(C, dtype=jnp.float32)
    diff = n[:, None] - n[None, :]
    inner_decay = jnp.where(diff[None] >= 0, jnp.exp(jnp.maximum(diff, 0.0)[None] * log_g[:, None, None]), 0.0).astype(q.dtype)
    cross_decay = jnp.exp((n[None] + 1.0) * log_g[:, None]).astype(q.dtype)
    key_decay = jnp.exp((C - 1.0 - n[None]) * log_g[:, None]).astype(q.dtype)
    chunk_decay = jnp.exp(C * log_g).astype(q.dtype)

    def to_chunks(t):
        return jnp.transpose(t.reshape(B, NC, C, H, t.shape[-1]), (1, 0, 3, 2, 4))

    def step(state, inp):
        qc, kc, vc = inp
        scores = jnp.einsum('bhnd,bhmd->bhnm', qc, kc) * inner_decay[None]
        inner = jnp.einsum('bhnm,bhme->bhne', scores, vc)
        cross = jnp.einsum('bhnd,bhde->bhne', qc, state) * cross_decay[None, :, :, None]
        new_state = state * chunk_decay[None, :, None, None] + jnp.einsum('bhmd,bhme->bhde', kc * key_decay[None, :, :, None], vc)
        return new_state, inner + cross

    state0 = jnp.zeros((B, H, dk, dv), q.dtype)
    _, ys = lax.scan(step, state0, (to_chunks(q), to_chunks(k), to_chunks(v)))
    return jnp.transpose(ys, (1, 0, 3, 2, 4)).reshape(B, S, H, dv)


def hierarchical_moe(h, w_group_router, b_group, w_inner_router, b_inner, w_gate, w_up, w_down):
    N = h.shape[0]
    group_logits = (h @ w_group_router).astype(jnp.float32) + b_group.astype(jnp.float32)
    group_probs = jax.nn.softmax(group_logits, axis=-1)
    g_idx = jnp.argmax(group_logits, axis=-1)
    p_group = jnp.take_along_axis(group_probs, g_idx[:, None], axis=1)
    inner_all = jnp.einsum('nd,gde->nge', h, w_inner_router).astype(jnp.float32)
    inner = jnp.take_along_axis(inner_all, g_idx[:, None, None], axis=1)[:, 0] + b_inner[g_idx].astype(jnp.float32)
    top_vals, top_idx = lax.top_k(inner, TOP_K_INNER)
    gates = p_group * jax.nn.softmax(top_vals, axis=-1)
    expert_id = (g_idx[:, None] * EXPERTS_PER_GROUP + top_idx).reshape(-1)
    order = jnp.argsort(expert_id)
    token = order // TOP_K_INNER
    xs = h[token]
    sizes = jnp.bincount(expert_id, length=N_EXPERTS).astype(jnp.int32)
    a = lax.ragged_dot(xs, w_gate, sizes)
    b = lax.ragged_dot(xs, w_up, sizes)
    ys = lax.ragged_dot(jax.nn.silu(a) * b, w_down, sizes)
    ys = ys * gates.reshape(-1)[order][:, None].astype(ys.dtype)
    return jnp.zeros((N, h.shape[1]), ys.dtype).at[token].add(ys)


def setup_inputs(seed: int = 0) -> dict:
    key = jax.random.key(seed)
    ks = jax.random.split(key, 20)
    f32 = jnp.float32
    nrm = lambda k, shape, s: jax.random.normal(k, shape, f32) * s
    return {
        "x": nrm(ks[0], (BATCH, SEQ, D_MODEL), 1.0),
        "rel_bias": nrm(ks[1], (N_BUCKETS, N_DIFF_HEADS), 0.5),
        "attn_norm_g": 1.0 + nrm(ks[2], (DEPTH, D_MODEL), 0.02),
        "w_in": nrm(ks[3], (DEPTH, D_MODEL, IN_COLS), D_MODEL ** -0.5),
        "lambda_q1": nrm(ks[4], (DEPTH, DIFF_HEAD_DIM), 0.1),
        "lambda_k1": nrm(ks[5], (DEPTH, DIFF_HEAD_DIM), 0.1),
        "lambda_q2": nrm(ks[6], (DEPTH, DIFF_HEAD_DIM), 0.1),
        "lambda_k2": nrm(ks[7], (DEPTH, DIFF_HEAD_DIM), 0.1),
        "diff_subln_g": 1.0 + nrm(ks[8], (DEPTH, DIFF_V_DIM), 0.02),
        "ret_gn_g": 1.0 + nrm(ks[9], (DEPTH, RET_WIDTH), 0.02),
        "w_out": nrm(ks[10], (DEPTH, MIX_WIDTH, D_MODEL), MIX_WIDTH ** -0.5),
        "ffn_norm_g": 1.0 + nrm(ks[11], (DEPTH, D_MODEL), 0.02),
        "w_group_router": nrm(ks[12], (DEPTH, D_MODEL, N_GROUPS), D_MODEL ** -0.5),
        "b_group": nrm(ks[13], (DEPTH, N_GROUPS), 0.01),
        "w_inner_router": nrm(ks[14], (DEPTH, N_GROUPS, D_MODEL, EXPERTS_PER_GROUP), D_MODEL ** -0.5),
        "b_inner": nrm(ks[15], (DEPTH, N_GROUPS, EXPERTS_PER_GROUP), 0.01),
        "w_gate_exp": nrm(ks[16], (DEPTH, N_EXPERTS, D_MODEL, D_FF_EXPERT), D_MODEL ** -0.5),
        "w_up_exp": nrm(ks[17], (DEPTH, N_EXPERTS, D_MODEL, D_FF_EXPERT), D_MODEL ** -0.5),
        "w_down_exp": nrm(ks[18], (DEPTH, N_EXPERTS, D_FF_EXPERT, D_MODEL), D_FF_EXPERT ** -0.5),
        "final_g": 1.0 + nrm(ks[19], (D_MODEL,), 0.02),
    }


def reference(x, rel_bias, attn_norm_g, w_in, lambda_q1, lambda_k1, lambda_q2, lambda_k2,
              diff_subln_g, ret_gn_g, w_out, ffn_norm_g, w_group_router, b_group,
              w_inner_router, b_inner, w_gate_exp, w_up_exp, w_down_exp, final_g):
    B, S, D = x.shape
    pos = jnp.arange(S)
    for l in range(DEPTH):
        h = rms_norm(x, attn_norm_g[l])
        proj = h @ w_in[l]
        cuts = list(np.cumsum(COL_SPLITS)[:-1])
        dq, dk_, dv_, rq, rk, rv, rg = jnp.split(proj, cuts, axis=-1)

        lam_init = 0.8 - 0.6 * math.exp(-0.3 * l)
        lam = (jnp.exp(jnp.sum(lambda_q1[l] * lambda_k1[l]).astype(jnp.float32))
               - jnp.exp(jnp.sum(lambda_q2[l] * lambda_k2[l]).astype(jnp.float32)) + lam_init)
        dq = dq.reshape(B, S, N_DIFF_HEADS, 2, DIFF_HEAD_DIM)
        dk_ = dk_.reshape(B, S, N_DIFF_HEADS, 2, DIFF_HEAD_DIM)
        dv_ = dv_.reshape(B, S, N_DIFF_HEADS, DIFF_V_DIM)
        a_out = diff_attention(dq, dk_, dv_, rel_bias, lam)
        a_out = rms_norm(a_out, diff_subln_g[l]) * (1.0 - lam_init)
        a_out = a_out.reshape(B, S, DIFF_WIDTH)

        rq = rotary(rq.reshape(B, S, N_RET_HEADS, RET_QK_DIM), pos)
        rk = rotary(rk.reshape(B, S, N_RET_HEADS, RET_QK_DIM), pos) * (RET_QK_DIM ** -0.5)
        rv = rv.reshape(B, S, N_RET_HEADS, RET_V_DIM)
        r = retention(rq, rk, rv).astype(jnp.float32)
        mu = jnp.mean(r, axis=-1, keepdims=True)
        var = jnp.mean(jnp.square(r - mu), axis=-1, keepdims=True)
        r = ((r - mu) * lax.rsqrt(var + EPS)).reshape(B, S, RET_WIDTH) * ret_gn_g[l].astype(jnp.float32)
        r_out = (jax.nn.silu(rg) * r.astype(x.dtype))

        mixed = jnp.concatenate([a_out.astype(x.dtype), r_out], axis=-1)
        x = x + mixed @ w_out[l]

        h2 = rms_norm(x, ffn_norm_g[l]).reshape(B * S, D)
        y = hierarchical_moe(h2, w_group_router[l], b_group[l], w_inner_router[l], b_inner[l],
                             w_gate_exp[l], w_up_exp[l], w_down_exp[l])
        x = x + y.reshape(B, S, D).astype(x.dtype)
    return rms_norm(x, final_g)
```

```cpp
#include <hip/hip_runtime.h>
#include <cstdio>
#include <cstdint>
#include <type_traits>

#ifndef BG_MODE
#define BG_MODE 3
#endif
#ifndef FORCE_NOMIX
#define FORCE_NOMIX 0
#endif
#ifndef MK_N_LAUNCHES
#define MK_N_LAUNCHES 1
#endif
constexpr int N_PHASES = 9;
constexpr int N_LAUNCHES = MK_N_LAUNCHES;

constexpr int BATCH = 8, SEQ = 2048, DM = 2048, NTOK = BATCH * SEQ;
constexpr int NPROJ = 6144;
constexpr int C_DQ = 0, C_DK = 1024, C_DV = 2048, C_RQ = 3072, C_RK = 3584, C_RV = 4096, C_RG = 5120;
constexpr int NEXP = 32, FF = 1024;
constexpr int XS_ROWS = 40960;
constexpr float EPS = 1e-6f;
constexpr float LOG2E = 1.4426950408889634f;
constexpr float YSCALE = 16.0f;
constexpr float QSCALE = 0.125f * LOG2E;

constexpr size_t MiB = 1u << 20;
constexpr size_t WS_CTL = 0, CTL_ZERO_BYTES = 1 * MiB;
constexpr size_t WS_ROPE = 1 * MiB;
constexpr size_t WS_TB = 1 * MiB + 512 * 1024;
constexpr size_t WS_WRH = 2 * MiB, WS_WRL = 2 * MiB + 256 * 1024;
constexpr size_t WS_TOK = 3 * MiB;
constexpr size_t TOK_E = 0, TOK_RANK = 128 * 1024, TOK_GATE = 256 * 1024, TOK_RS2 = 384 * 1024, TOK_POS = 448 * 1024, ROW_GATE = 576 * 1024, ROW_RS = 736 * 1024;
constexpr size_t WS_SROW = 2 * MiB + 512 * 1024;
constexpr size_t WS_BTIN = 4 * MiB, WS_BTOUT = 28 * MiB, WS_BTGU = 36 * MiB, WS_BTD = 292 * MiB;
constexpr size_t WS_XN = 420 * MiB, WS_MIX = 484 * MiB, WS_ACT = 420 * MiB;
constexpr size_t WS_PROJ = 548 * MiB, WS_Y = 548 * MiB, WS_XG = 708 * MiB;
constexpr size_t WS_X1 = 772 * MiB, WS_LST = 840 * MiB, WS_END = 900 * MiB;
constexpr int CW_TMO = 0, CW_CODE = 1, CW_BAR = 4096, CW_CNT = 16384;

constexpr int RING_OFF = 0, RING_BYTES = 131072;
constexpr int LDSCTL_OFF = 139264, MISC_OFF = LDSCTL_OFF + 320;
constexpr int LTAB_OFF = LDSCTL_OFF + 1024;
constexpr int LDS_BYTES = 147456;

#define GAS __attribute__((address_space(1)))
#define LAS __attribute__((address_space(3)))
typedef unsigned short bf16;
typedef unsigned v4u __attribute__((ext_vector_type(4)));
typedef unsigned v2u __attribute__((ext_vector_type(2)));
typedef float f32x4 __attribute__((ext_vector_type(4)));
typedef float f32x2 __attribute__((ext_vector_type(2)));
typedef float f32x16 __attribute__((ext_vector_type(16)));
typedef short bf16x8 __attribute__((ext_vector_type(8)));
typedef short s16x4 __attribute__((ext_vector_type(4)));
typedef GAS unsigned gu32;
#define RLX_AGENT __ATOMIC_RELAXED, __HIP_MEMORY_SCOPE_AGENT
#define LDS_WAIT() asm volatile("s_waitcnt lgkmcnt(0)" ::: "memory")
#define VM_WAIT() asm volatile("s_waitcnt vmcnt(0)" ::: "memory")

__device__ __forceinline__ unsigned f2bf(float f) { unsigned u = __builtin_bit_cast(unsigned, f); return (u + 0x7fffu + ((u >> 16) & 1u)) >> 16; }
__device__ __forceinline__ unsigned pk2(float lo, float hi) { return f2bf(lo) | (f2bf(hi) << 16); }
__device__ __forceinline__ float bf2f(unsigned short b) { return __builtin_bit_cast(float, (unsigned)b << 16); }
__device__ __forceinline__ unsigned cvt_pk_bf16(float lo, float hi) { unsigned r; asm volatile("v_cvt_pk_bf16_f32 %0, %1, %2" : "=v"(r) : "v"(lo), "v"(hi)); return r; }
__device__ __forceinline__ unsigned pk4_fp8(float a, float b, float c, float d) { unsigned w = 0u; w = (unsigned)__builtin_amdgcn_cvt_pk_fp8_f32(a, b, (int)w, false); w = (unsigned)__builtin_amdgcn_cvt_pk_fp8_f32(c, d, (int)w, true); return w; }
__device__ __forceinline__ float wave_sum(float v) {
#pragma unroll
    for (int o = 1; o < 64; o <<= 1) v += __shfl_xor(v, o);
    return v;
}

namespace pg8 {
#define PG8_LAS __attribute__((address_space(3)))
typedef unsigned short bf16_t;
typedef int v4i_t __attribute__((ext_vector_type(4)));
typedef int v8i_t __attribute__((ext_vector_type(8)));
constexpr int LCAP = 16384;
constexpr int BM = 256, BK = 64, HALF = 128, HTB = HALF * BK * 2, STAGE_BYTES = 8 * HTB, NXCD = 8, WGM = 8;
__host__ __device__ __forceinline__ int lds_byte(int r, int c) { const int st = (r >> 4) * 2 + (c >> 5), rr = r & 15, cc = c & 31, ob = rr * 64 + cc * 2; return st * 1024 + (ob ^ (((ob >> 9) & 1) << 5)); }
__host__ __device__ __forceinline__ void stage_rc(int b, int& R, int& C) { const int st = b / 1024, sb = b % 1024, swz = sb ^ (((sb >> 9) & 1) << 5); R = (st >> 1) * 16 + swz / 64; C = (st & 1) * 32 + (swz % 64) / 2; }
__host__ __device__ __forceinline__ int perm32(int rho) { const int n = rho >> 4, i = rho & 15; return 8 * (i >> 2) + 4 * n + (i & 3); }

struct Unit { int pm, pn, e, rl0, cnt; };
struct Gemm { const void* A; const void* Bt; int Kb; size_t bstride; const int* lst; };

struct StaticOrder {
    int nM, nN, nwg, G, c;
    int reps;
    __device__ void init(int M, int N, int G_, int c_, int reps_ = 1) { nM = M / BM; nN = N / BM; nwg = nM * nN; G = G_; c = c_; reps = reps_; }
    __device__ bool next(int i, Unit& u) const {
        const long L0 = (long)i * G + c; if (L0 >= (long)nwg * reps) return false;
        const long L = L0 % nwg;
        int wgid = (int)L; { const int q = nwg / NXCD, r = nwg % NXCD, xcd = wgid % NXCD, off = wgid / NXCD; wgid = (xcd < r ? xcd * (q + 1) : r * (q + 1) + (xcd - r) * q) + off; }
        const int nig = WGM * nN, gid = wgid / nig, fm = gid * WGM, gsz = (nM - fm) < WGM ? (nM - fm) : WGM;
        u.pm = fm + ((wgid % nig) % gsz); u.pn = (wgid % nig) / gsz; u.e = 0; u.rl0 = 0; u.cnt = 0; return true;
    }
};
struct GroupOrder {
    int ntiles, nN, G, c; const PG8_LAS int* tab;
    int L0, Lend;
    __device__ bool next(int i, Unit& u) const {
        const int L = L0 + i * G + c; if (L < 0 || L >= Lend) return false;
        const int t = L / nN; u.pm = t; u.pn = L - t * nN; u.e = __builtin_amdgcn_readfirstlane(tab[128 + t]);
        u.rl0 = t * BM - __builtin_amdgcn_readfirstlane(tab[u.e]); u.cnt = __builtin_amdgcn_readfirstlane(tab[96 + u.e]); return true;
    }
};

template <class Epi, class Sched, bool GATHER = false, bool F8 = false, int SA = 127, int SB = 127>
__device__ __forceinline__ void gemm_phase(PG8_LAS unsigned char* lds, const Gemm g, const Sched& S, const Epi& E) {
    const int tid = threadIdx.x, wid = __builtin_amdgcn_readfirstlane(tid >> 6), lane = tid & 63, wr = wid >> 2, wc = wid & 3, fr = lane & 15, fq = lane >> 4;
    const int Kb = g.Kb, nt = Kb / 128;
    unsigned voffA[2], voffB[2];
#pragma unroll
    for (int i = 0; i < 2; ++i) { int R, C; stage_rc(tid * 16 + i * 8192, R, C); const int Rb = Epi::PERM ? ((R & ~31) + perm32(R & 31)) : R;
        voffA[i] = (unsigned)(R * Kb + C * 2); voffB[i] = (unsigned)(Rb * Kb + C * 2); }
    unsigned vC[2][2], vN[2][2];
#define PG8_GOFF(dst, u_) do { _Pragma("unroll") for (int _h = 0; _h < 2; ++_h) _Pragma("unroll") for (int _i = 0; _i < 2; ++_i) { int R_, C_; stage_rc(tid * 16 + _i * 8192, R_, C_); \
        const int rl_ = (u_).rl0 + _h * HALF + R_; const int tk_ = rl_ < (u_).cnt ? g.lst[(u_).e * LCAP + rl_] : 0; dst[_h][_i] = (unsigned)(tk_ * Kb + C_ * 2); } } while (0)
    const size_t kstep = (size_t)(BK * 2);
    const size_t hstep = (size_t)HALF * Kb;
    const size_t tstep = 2 * hstep;
    const unsigned ldsw = (unsigned)wid * 1024u;
    const int aoff = lds_byte(wr * 64 + fr, fq * 8), boff = lds_byte(wc * 32 + fr, fq * 8);
#define PG8_SA(b, h) (((b) * 2 + (h)) * HTB)
#define PG8_SB(b, h) ((4 + (b) * 2 + (h)) * HTB)
#define PG8_STAGE(bufoff, gbase, voff) do { _Pragma("unroll") for (int _i = 0; _i < 2; ++_i) \
        __builtin_amdgcn_global_load_lds((const unsigned*)((const char*)(gbase) + (voff)[_i]), (PG8_LAS unsigned*)(lds + (bufoff) + ldsw + _i * 8192), 16, 0, 0); } while (0)
#define PG8_STAGE_A(bufoff, gbase, hh, nx) do { if constexpr (GATHER) { _Pragma("unroll") for (int _i = 0; _i < 2; ++_i) { const unsigned _v = (nx) ? vN[hh][_i] : vC[hh][_i]; \
        __builtin_amdgcn_global_load_lds((const unsigned*)((const char*)(gbase) + _v), (PG8_LAS unsigned*)(lds + (bufoff) + ldsw + _i * 8192), 16, 0, 0); } } \
        else { PG8_STAGE(bufoff, (gbase) + (hh) * hstep, voffA); } } while (0)
#define PG8_LDA(dst, b, h) do { if constexpr (F8) { _Pragma("unroll") for (int m = 0; m < 4; ++m) { const v4i_t lo_ = *(const PG8_LAS v4i_t*)(lds + PG8_SA(b, h) + aoff + m * 2048), hi_ = *(const PG8_LAS v4i_t*)(lds + PG8_SA(b, h) + aoff + m * 2048 + 1024); \
            dst##8[m] = __builtin_shufflevector(lo_, hi_, 0, 1, 2, 3, 4, 5, 6, 7); } } \
        else { _Pragma("unroll") for (int m = 0; m < 4; ++m) _Pragma("unroll") for (int k = 0; k < 2; ++k) dst[m][k] = *(const PG8_LAS bf16x8*)(lds + PG8_SA(b, h) + aoff + m * 2048 + k * 1024); } } while (0)
#define PG8_LDB(dst, b, h) do { if constexpr (F8) { _Pragma("unroll") for (int n = 0; n < 2; ++n) { const v4i_t lo_ = *(const PG8_LAS v4i_t*)(lds + PG8_SB(b, h) + boff + n * 2048), hi_ = *(const PG8_LAS v4i_t*)(lds + PG8_SB(b, h) + boff + n * 2048 + 1024); \
            dst##8[n] = __builtin_shufflevector(lo_, hi_, 0, 1, 2, 3, 4, 5, 6, 7); } } \
        else { _Pragma("unroll") for (int n = 0; n < 2; ++n) _Pragma("unroll") for (int k = 0; k < 2; ++k) dst[n][k] = *(const PG8_LAS bf16x8*)(lds + PG8_SB(b, h) + boff + n * 2048 + k * 1024); } } while (0)
#define PG8_MMA(ai, bj, At, Bt) do { __builtin_amdgcn_s_setprio(1); \
        if constexpr (F8) { _Pragma("unroll") for (int m = 0; m < 4; ++m) _Pragma("unroll") for (int n = 0; n < 2; ++n) \
            asm volatile("v_mfma_scale_f32_16x16x128_f8f6f4 %0, %1, %2, %0, %3, %4 op_sel_hi:[0,0,0]" : "+v"(acc[ai][bj][m][n]) : "v"(Bt##8[n]), "v"(At##8[m]), "v"(sca), "v"(scb)); } \
        else { _Pragma("unroll") for (int m = 0; m < 4; ++m) _Pragma("unroll") for (int n = 0; n < 2; ++n) _Pragma("unroll") for (int k = 0; k < 2; ++k) \
            acc[ai][bj][m][n] = __builtin_amdgcn_mfma_f32_16x16x32_bf16(Bt[n][k], At[m][k], acc[ai][bj][m][n], 0, 0, 0); } \
        __builtin_amdgcn_s_setprio(0); } while (0)
#define PG8_WAIT_V(n) asm volatile("s_waitcnt vmcnt(" #n ")" ::: "memory")
#define PG8_WAIT_L(n) asm volatile("s_waitcnt lgkmcnt(" #n ")" ::: "memory")
#define PG8_BAR __builtin_amdgcn_s_barrier()
#define PG8_SCHED __builtin_amdgcn_sched_barrier(0)
    Unit cur, nxt; int ui = 0;
    if (!S.next(0, cur)) return;
    f32x4 acc[2][2][4][2];
#pragma unroll
    for (int a = 0; a < 2; ++a)
#pragma unroll
        for (int b = 0; b < 2; ++b)
#pragma unroll
            for (int m = 0; m < 4; ++m)
#pragma unroll
                for (int n = 0; n < 2; ++n) acc[a][b][m][n] = (f32x4){0.f, 0.f, 0.f, 0.f};
    const int sca = SA, scb = SB;
    bf16x8 At[4][2], B0[2][2], B1[2][2]; v8i_t At8[4], B08[2], B18[2];
    const char* cA = GATHER ? (const char*)g.A : (const char*)g.A + (size_t)cur.pm * tstep; const char* cB = (const char*)g.Bt + (size_t)cur.e * g.bstride + (size_t)cur.pn * tstep;
    if constexpr (GATHER) { PG8_GOFF(vC, cur); }
    PG8_STAGE(PG8_SB(0, 0), cB, voffB); PG8_STAGE(PG8_SB(0, 1), cB + hstep, voffB); PG8_STAGE_A(PG8_SA(0, 0), cA, 0, false); PG8_STAGE_A(PG8_SA(0, 1), cA, 1, false);
    if (wr == 1) PG8_BAR;
    PG8_WAIT_V(2); PG8_BAR;
    PG8_STAGE(PG8_SB(1, 0), cB + kstep, voffB); PG8_STAGE_A(PG8_SA(1, 0), cA + kstep, 0, false); PG8_STAGE(PG8_SB(1, 1), cB + hstep + kstep, voffB);
    PG8_WAIT_V(6); PG8_BAR;
    for (;;) {
        const bool has_next = S.next(ui + 1, nxt);
        const char* nA = GATHER ? cA : (has_next ? (const char*)g.A + (size_t)nxt.pm * tstep : cA);
        if constexpr (GATHER) { if (has_next) { PG8_GOFF(vN, nxt); } else {
#pragma unroll
            for (int _h = 0; _h < 2; ++_h)
#pragma unroll
                for (int _i = 0; _i < 2; ++_i) vN[_h][_i] = vC[_h][_i]; } }
        const char* nB = has_next ? (const char*)g.Bt + (size_t)nxt.e * g.bstride + (size_t)nxt.pn * tstep : cB;
#pragma unroll 1
        for (int t = 0; t < nt; t += 2) {
            const bool last = (t == nt - 2);
            const char* a1 = cA + (size_t)(t + 1) * kstep;
            const char* a2 = last ? nA : cA + (size_t)(t + 2) * kstep; const char* b2 = last ? nB : cB + (size_t)(t + 2) * kstep;
            const char* a3 = a2 + kstep; const char* b3 = b2 + kstep;
            PG8_LDB(B0, 0, 0); PG8_LDB(B1, 0, 1); PG8_SCHED; PG8_LDA(At, 0, 0); PG8_STAGE_A(PG8_SA(1, 1), a1, 1, false);
            PG8_WAIT_V(8); PG8_WAIT_L(0); PG8_BAR; PG8_MMA(0, 0, At, B0); PG8_MMA(0, 1, At, B1); PG8_BAR; PG8_SCHED;
            PG8_LDA(At, 0, 1); PG8_STAGE(PG8_SB(0, 0), b2, voffB); PG8_STAGE(PG8_SB(0, 1), b2 + hstep, voffB); PG8_STAGE_A(PG8_SA(0, 0), a2, 0, last);
            PG8_WAIT_V(8); PG8_WAIT_L(0); PG8_BAR; PG8_MMA(1, 0, At, B0); PG8_MMA(1, 1, At, B1); PG8_BAR; PG8_SCHED;
            PG8_LDB(B0, 1, 0); PG8_LDB(B1, 1, 1); PG8_SCHED; PG8_LDA(At, 1, 0); PG8_STAGE_A(PG8_SA(0, 1), a2, 1, last);
            PG8_WAIT_V(8); PG8_WAIT_L(0); PG8_BAR; PG8_MMA(0, 0, At, B0); PG8_MMA(0, 1, At, B1); PG8_BAR; PG8_SCHED;
            PG8_LDA(At, 1, 1); PG8_STAGE(PG8_SB(1, 0), b3, voffB); PG8_STAGE(PG8_SB(1, 1), b3 + hstep, voffB); PG8_STAGE_A(PG8_SA(1, 0), a3, 0, last);
            PG8_WAIT_V(8); PG8_WAIT_L(0); PG8_BAR; PG8_MMA(1, 0, At, B0); PG8_MMA(1, 1, At, B1); PG8_BAR; PG8_SCHED;
        }
        if (wr == 0) PG8_BAR;
        if constexpr (F8) asm volatile("s_nop 15\n\ts_nop 15" ::: "memory");
        E(acc, cur, wr, wc, fr, fq);
        if (!has_next) break;
#pragma unroll
        for (int a = 0; a < 2; ++a)
#pragma unroll
            for (int b = 0; b < 2; ++b)
#pragma unroll
                for (int m = 0; m < 4; ++m)
#pragma unroll
                    for (int n = 0; n < 2; ++n) acc[a][b][m][n] = (f32x4){0.f, 0.f, 0.f, 0.f};
        cur = nxt; cA = nA; cB = nB; ++ui;
        if constexpr (GATHER) {
#pragma unroll
            for (int _h = 0; _h < 2; ++_h)
#pragma unroll
                for (int _i = 0; _i < 2; ++_i) vC[_h][_i] = vN[_h][_i]; }
        if (wr == 1) PG8_BAR;
    }
    PG8_WAIT_V(0);
    PG8_BAR;
#undef PG8_SA
#undef PG8_SB
#undef PG8_STAGE
#undef PG8_STAGE_A
#undef PG8_GOFF
#undef PG8_LDA
#undef PG8_LDB
#undef PG8_MMA
#undef PG8_WAIT_V
#undef PG8_WAIT_L
#undef PG8_BAR
#undef PG8_SCHED
}

struct EpiProj {
    static constexpr bool PERM = true;
    bf16_t* O; const f32x2* rope;
    __device__ __forceinline__ void operator()(const f32x4 (&acc)[2][2][4][2], const Unit& u, int wr, int wc, int fr, int fq) const {
        const int row0 = u.pm * BM + wr * 64 + fr, col0 = u.pn * BM + wc * 32 + 8 * fq;
        const int mode = (u.pn < 4) ? 1 : ((u.pn >= 12 && u.pn < 16) ? 2 : 0);
        const float sc = (mode == 1) ? QSCALE : ((u.pn >= 14 && u.pn < 16) ? 0.125f : 1.0f);
#pragma unroll
        for (int ai = 0; ai < 2; ++ai)
#pragma unroll
            for (int m = 0; m < 4; ++m) { const int row = row0 + ai * HALF + m * 16; bf16_t* rowp = O + (size_t)row * NPROJ + col0;
#pragma unroll
                for (int bj = 0; bj < 2; ++bj) { f32x4 v0 = acc[ai][bj][m][0], v1 = acc[ai][bj][m][1];
                    if (mode == 2) { const int t0 = ((col0 + bj * HALF) & 63) >> 1; const f32x4* rp = (const f32x4*)(rope + (size_t)(row & (SEQ - 1)) * 32 + t0);
                        const f32x4 c0 = rp[0], c1 = rp[1];
                        f32x4 w0, w1;
                        w0[0] = v0[0] * c0[0] - v0[1] * c0[1]; w0[1] = v0[0] * c0[1] + v0[1] * c0[0];
                        w0[2] = v0[2] * c0[2] - v0[3] * c0[3]; w0[3] = v0[2] * c0[3] + v0[3] * c0[2];
                        w1[0] = v1[0] * c1[0] - v1[1] * c1[1]; w1[1] = v1[0] * c1[1] + v1[1] * c1[0];
                        w1[2] = v1[2] * c1[2] - v1[3] * c1[3]; w1[3] = v1[2] * c1[3] + v1[3] * c1[2];
                        v0 = w0; v1 = w1; }
                    v0 = v0 * sc; v1 = v1 * sc; v4u w; w.x = cvt_pk_bf16(v0[0], v0[1]); w.y = cvt_pk_bf16(v0[2], v0[3]); w.z = cvt_pk_bf16(v1[0], v1[1]); w.w = cvt_pk_bf16(v1[2], v1[3]);
                    *(v4u*)(rowp + bj * HALF) = w; } }
    }
};
struct EpiRes {
    static constexpr bool PERM = true;
    const bf16_t* xn; const float* irs1; const float* g1; bf16_t* X1; unsigned char* XG; const float* g2;
    __device__ __forceinline__ void operator()(const f32x4 (&acc)[2][2][4][2], const Unit& u, int wr, int wc, int fr, int fq) const {
        const int row0 = u.pm * BM + wr * 64 + fr, col0 = u.pn * BM + wc * 32 + 8 * fq;
        f32x4 g[2][2], ig[2][2];
#pragma unroll
        for (int bj = 0; bj < 2; ++bj)
#pragma unroll
            for (int n = 0; n < 2; ++n) { g[bj][n] = *(const f32x4*)(g2 + col0 + bj * HALF + 4 * n); const f32x4 t = *(const f32x4*)(g1 + col0 + bj * HALF + 4 * n); ig[bj][n] = (f32x4){1.0f / t[0], 1.0f / t[1], 1.0f / t[2], 1.0f / t[3]}; }
#pragma unroll
        for (int ai = 0; ai < 2; ++ai) {
            v4u xb[4][2]; float ir[4];
#pragma unroll
            for (int m = 0; m < 4; ++m) { ir[m] = irs1[row0 + ai * HALF + m * 16];
#pragma unroll
                for (int bj = 0; bj < 2; ++bj) xb[m][bj] = *(const v4u*)(xn + (size_t)(row0 + ai * HALF + m * 16) * DM + col0 + bj * HALF); }
#pragma unroll
            for (int m = 0; m < 4; ++m) { const size_t off = (size_t)(row0 + ai * HALF + m * 16) * DM + col0;
#pragma unroll
                for (int bj = 0; bj < 2; ++bj) { const v4u xw = xb[m][bj]; const float rr = ir[m];
                    const f32x4 x0 = (f32x4){bf2f(xw.x & 0xffff), bf2f(xw.x >> 16), bf2f(xw.y & 0xffff), bf2f(xw.y >> 16)} * ig[bj][0] * rr, x1 = (f32x4){bf2f(xw.z & 0xffff), bf2f(xw.z >> 16), bf2f(xw.w & 0xffff), bf2f(xw.w >> 16)} * ig[bj][1] * rr;
                    const f32x4 v0 = x0 + acc[ai][bj][m][0], v1 = x1 + acc[ai][bj][m][1];
                    v4u w; w.x = cvt_pk_bf16(v0[0], v0[1]); w.y = cvt_pk_bf16(v0[2], v0[3]); w.z = cvt_pk_bf16(v1[0], v1[1]); w.w = cvt_pk_bf16(v1[2], v1[3]);
                    *(v4u*)(X1 + off + bj * HALF) = w;
                    const float r0 = bf2f(w.x & 0xffff), r1 = bf2f(w.x >> 16), r2 = bf2f(w.y & 0xffff), r3 = bf2f(w.y >> 16), r4 = bf2f(w.z & 0xffff), r5 = bf2f(w.z >> 16), r6 = bf2f(w.w & 0xffff), r7 = bf2f(w.w >> 16);
                    v2u q; q.x = pk4_fp8(r0 * g[bj][0][0], r1 * g[bj][0][1], r2 * g[bj][0][2], r3 * g[bj][0][3]); q.y = pk4_fp8(r4 * g[bj][1][0], r5 * g[bj][1][1], r6 * g[bj][1][2], r7 * g[bj][1][3]);
                    *(v2u*)(XG + off + bj * HALF) = q; } } }
    }
};
struct EpiSwiglu {
    static constexpr bool PERM = true;
    unsigned char* O; const float* lst_rs;
    __device__ __forceinline__ void operator()(const f32x4 (&acc)[2][2][4][2], const Unit& u, int wr, int wc, int fr, int fq) const {
        const int row0 = u.pm * BM + wr * 64 + fr, f0 = u.pn * 128 + wc * 16 + 4 * fq;
#pragma unroll
        for (int ai = 0; ai < 2; ++ai)
#pragma unroll
            for (int m = 0; m < 4; ++m) { const int row = row0 + ai * HALF + m * 16; const float rs = lst_rs[u.e * LCAP + u.rl0 + (row - u.pm * BM)]; unsigned char* rowp = O + (size_t)row * FF + f0;
#pragma unroll
                for (int bj = 0; bj < 2; ++bj) { const f32x4 a = acc[ai][bj][m][0] * rs, b = acc[ai][bj][m][1] * rs; f32x4 r;
#pragma unroll
                    for (int j = 0; j < 4; ++j) r[j] = a[j] * __builtin_amdgcn_rcpf(1.0f + __builtin_amdgcn_exp2f(-a[j] * LOG2E)) * b[j];
                    *(unsigned*)(rowp + bj * 64) = pk4_fp8(r[0], r[1], r[2], r[3]); } }
    }
};
struct EpiDown {
    static constexpr bool PERM = true;
    unsigned char* O; const float* lst_gate;
    __device__ __forceinline__ void operator()(const f32x4 (&acc)[2][2][4][2], const Unit& u, int wr, int wc, int fr, int fq) const {
        const int row0 = u.pm * BM + wr * 64 + fr, col0 = u.pn * BM + wc * 32 + 8 * fq;
#pragma unroll
        for (int ai = 0; ai < 2; ++ai)
#pragma unroll
            for (int m = 0; m < 4; ++m) { const int row = row0 + ai * HALF + m * 16; const float gt = lst_gate[u.e * LCAP + u.rl0 + (row - u.pm * BM)] * YSCALE; unsigned char* rowp = O + (size_t)row * DM + col0;
#pragma unroll
                for (int bj = 0; bj < 2; ++bj) { const f32x4 v0 = acc[ai][bj][m][0] * gt, v1 = acc[ai][bj][m][1] * gt;
                    v2u w; w.x = pk4_fp8(v0[0], v0[1], v0[2], v0[3]); w.y = pk4_fp8(v1[0], v1[1], v1[2], v1[3]);
                    *(v2u*)(rowp + bj * HALF) = w; } }
    }
};
}

namespace att {
constexpr int KOFF0 = 0, KOFF1 = 8192, VOFF = 16384, BUFB = 32768;
constexpr int TBOFF = 65536, WSFOFF = 66816, QFOFF0 = 69632, QFOFF1 = 98304;
constexpr int STG_PITCH = 132, STG_WAVE = 32 * STG_PITCH * 4;
constexpr float THR = 8.0f;
__device__ __forceinline__ int crow(int r, int hi) { return (r & 3) + 8 * (r >> 2) + 4 * hi; }
__device__ __forceinline__ s16x4 vtr(const LAS unsigned char* p) { typedef short v4i16_t __attribute__((ext_vector_type(4))); return __builtin_bit_cast(s16x4, __builtin_amdgcn_ds_read_tr16_b64_v4i16((LAS v4i16_t*)p)); }

struct Args { const bf16* proj; bf16* mix; const float* tb; const float* subln_g; const float* gn_g; float lam; };

#define ATT_SRC(L) unsigned ksrc, vsrc; \
    { const int row_ = 8 * wid + ((L) >> 3), slot_ = (L) & 7, ch_ = slot_ ^ ((row_ >> 1) & 7); ksrc = (unsigned)(row_ * NPROJ + ck + ch_ * 8) * 2u; } \
    { const int row_ = 8 * wid + ((L) >> 4), slot_ = (L) & 15; vsrc = (unsigned)(row_ * NPROJ + cv + ((slot_ ^ ((row_ & 3) << 2)) * 8)) * 2u; }
#define ATT_STAGE(t, bufo) do { const char* _b = pbase + (size_t)(t) * 64 * NPROJ * 2; \
        __builtin_amdgcn_global_load_lds((const unsigned*)(_b + ksrc), (LAS unsigned*)(lds + (bufo) + KOFF0 + ldsw), 16, 0, 0); \
        if (MODE == 0) __builtin_amdgcn_global_load_lds((const unsigned*)(_b + ksrc + 128), (LAS unsigned*)(lds + (bufo) + KOFF1 + ldsw), 16, 0, 0); \
        __builtin_amdgcn_global_load_lds((const unsigned*)(_b + vsrc), (LAS unsigned*)(lds + (bufo) + VOFF + 2 * ldsw), 16, 0, 0); \
        __builtin_amdgcn_global_load_lds((const unsigned*)(_b + vsrc + 4 * NPROJ * 2), (LAS unsigned*)(lds + (bufo) + VOFF + 2 * ldsw + 1024), 16, 0, 0); } while (0)

constexpr float WSCALE = 32.0f;
struct Bg { const float* wg; const float* wu; const float* wd; unsigned char* btgu; unsigned char* btd; int it, end; bool have; f32x4 r[8]; };
__device__ __forceinline__ void bg_decode(const Bg& B, int it, int lane, const float*& src, int& N, unsigned char*& dst, int& K) {
    const int me = it >> 10, r = it & 1023, e = me / 3, w = me - 3 * e, n4 = lane & 7, kr = lane >> 3;
    if (w == 2) { N = DM; K = FF; const int kb = r >> 6, nb = r & 63, nn = 32 * nb + 4 * n4, k0 = 64 * kb + 8 * kr; src = B.wd + (size_t)e * FF * DM + (size_t)k0 * DM + nn; dst = B.btd + (size_t)e * DM * FF + (size_t)nn * FF + k0; }
    else { N = FF; K = DM; const int kb = r >> 5, nb = r & 31, nn = 32 * nb + 4 * n4, k0 = 64 * kb + 8 * kr; src = (w == 0 ? B.wg : B.wu) + (size_t)e * DM * FF + (size_t)k0 * FF + nn;
           dst = B.btgu + (size_t)e * 2048 * DM + (size_t)(8 * (nn >> 2) + 4 * w) * DM + k0; }
}
__device__ __forceinline__ void bg_issue(Bg& B, int lane) {
    if (BG_MODE != 0 && B.it < B.end) { const float* src; unsigned char* dst; int N, K; bg_decode(B, B.it, lane, src, N, dst, K);
#pragma unroll
        for (int j = 0; j < 8; ++j) B.r[j] = __builtin_nontemporal_load((const f32x4*)(src + (size_t)j * N));
        B.have = true; ++B.it; }
}
__device__ __forceinline__ void bg_retire(Bg& B, int lane) {
    if (B.have) { const float* src; unsigned char* dst; int N, K; bg_decode(B, B.it - 1, lane, src, N, dst, K);
#pragma unroll
        for (int i = 0; i < 4; ++i) { v2u w; w.x = pk4_fp8(B.r[0][i] * WSCALE, B.r[1][i] * WSCALE, B.r[2][i] * WSCALE, B.r[3][i] * WSCALE); w.y = pk4_fp8(B.r[4][i] * WSCALE, B.r[5][i] * WSCALE, B.r[6][i] * WSCALE, B.r[7][i] * WSCALE);
            *(v2u*)(dst + (size_t)i * K) = w; }
        B.have = false; }
}

template <int MODE>
__device__ __forceinline__ void attn_unit(const Args& A, Bg& BG, int b, int h, int qb, LAS unsigned char* lds) {
    constexpr int NMAP = (MODE == 0) ? 2 : 1, NBUF = (MODE == 0) ? 2 : 3, QFOFF = (MODE == 0) ? QFOFF0 : QFOFF1, NGL = (MODE == 0) ? 4 : 3;
    int tid = threadIdx.x; asm volatile("" : "+v"(tid));
    const int lane = tid & 63, wid = __builtin_amdgcn_readfirstlane(tid >> 6);
    const int q0 = qb * 256, qw = q0 + wid * 32;
    const size_t rowbase = (size_t)b * SEQ;
    const int cq = (MODE == 0) ? C_DQ + h * 128 : C_RQ + h * 64;
    const int ck = (MODE == 0) ? C_DK + h * 128 : C_RK + h * 64;
    const int cv = (MODE == 0) ? C_DV + h * 128 : C_RV + h * 128;
    const int NT = (q0 + 256) / 64;
    const int ntw = (qw + 31) / 64 + 1;
    const char* pbase = (const char*)(A.proj + rowbase * NPROJ);
    const unsigned ldsw = (unsigned)wid * 1024u;
    LAS float* tbl = (LAS float*)(lds + TBOFF);
    { ATT_SRC(lane); ATT_STAGE(0, 0); if (NBUF == 3 && NT > 1) ATT_STAGE(1, BUFB); }
    if (MODE == 0) { if (tid < 304) tbl[tid] = A.tb[h * 304 + tid]; }
    { LAS unsigned char* qw_ = lds + QFOFF + wid * (NMAP * 4096) + lane * 16; const char* qg = pbase + (size_t)((qw + (lane & 31)) * NPROJ + cq + (lane >> 5) * 8) * 2;
#pragma unroll
      for (int f = 0; f < NMAP * 4; ++f) *(LAS v4u*)(qw_ + f * 1024) = *(const v4u*)(qg + (f >> 2) * 128 + (f & 3) * 32); }
    f32x16 o[NMAP][4];
#pragma unroll
    for (int c = 0; c < NMAP; ++c)
#pragma unroll
        for (int d = 0; d < 4; ++d)
#pragma unroll
            for (int r = 0; r < 16; ++r) o[c][d][r] = 0.f;
    float mref[NMAP], lsum[NMAP];
#pragma unroll
    for (int c = 0; c < NMAP; ++c) { mref[c] = -INFINITY; lsum[c] = 0.f; }
    float cg = 0.f;
    if (MODE == 1) { const double x = __builtin_ldexp(1.0, -5 - h); const double s = x * (1.0 + x * (0.5 + x * (1.0 / 3 + x * (0.25 + x * (0.2 + x * (1.0 / 6 + x * (1.0 / 7)))))));
        cg = (float)(-s * 1.4426950408889634); }
    VM_WAIT(); __syncthreads();
    for (int t = 0; t < NT; ++t) {
        const int bufo = (NBUF == 2 ? (t & 1) : (t % 3)) * BUFB, t0 = t * 64;
        int ln = lane; asm volatile("" : "+v"(ln));
        const bool staged = (t + NBUF - 1 < NT);
        if (staged) { ATT_SRC(ln); ATT_STAGE(t + NBUF - 1, ((t + NBUF - 1) % NBUF) * BUFB); }
        bool bg_now = false;
#define ATT_BGMID() do { bg_retire(BG, ln); const int ib_ = BG.it; if (MODE == 0 || (t % 3) == 0) bg_issue(BG, ln); bg_now = BG.it != ib_; } while (0)
        if (t >= ntw) ATT_BGMID();
        if (t < ntw) {
            const int r32 = ln & 31, hi = ln >> 5;
            const LAS unsigned char* kb = lds + bufo; const LAS unsigned char* vb = lds + bufo + VOFF;
            const bool near = (qw - t0) <= 175, diag = (t0 + 63) > qw;
            const int kbase = r32 * 128 + ((((r32 >> 2) & 3)) << 5) + ((hi ^ ((r32 >> 1) & 1)) << 4);
            int vbase;
            { const int i16 = ln & 15, q = i16 >> 2, p = i16 & 3, g = (ln >> 4) & 1; vbase = (4 * hi + q) * 256 + (((q << 2) + 2 * g + (p >> 1)) << 4) + 8 * (p & 1); }
            const LAS unsigned char* qlds = lds + QFOFF + wid * (NMAP * 4096) + ln * 16;
            LAS float* wsf = (LAS float*)(lds + WSFOFF) + wid * 64;
#pragma unroll
            for (int kh = 0; kh < 2; ++kh) {
              if (kh == 1) ATT_BGMID();
              if (t0 + 32 * kh > qw + 31) continue;
#pragma unroll
              for (int c = 0; c < NMAP; ++c) {
                f32x16 p;
                __builtin_amdgcn_sched_barrier(0);
                if (MODE == 0 && near) { const LAS float* tp = tbl + (207 - (qw + r32 - t0) + 4 * hi + 32 * kh);
#pragma unroll
                    for (int r = 0; r < 16; ++r) p[r] = tp[(r & 3) + 8 * (r >> 2)];
                } else { const float ini = (MODE == 0) ? tbl[0] : 0.f;
#pragma unroll
                    for (int r = 0; r < 16; ++r) p[r] = ini; }
#pragma unroll
                for (int s = 0; s < 4; ++s) {
                    const bf16x8 qf = *(const LAS bf16x8*)(qlds + (c * 4 + s) * 1024);
                    const bf16x8 kf = *(const LAS bf16x8*)(kb + c * KOFF1 + (kbase ^ (s << 5)) + kh * 4096);
                    p = __builtin_amdgcn_mfma_f32_32x32x16_bf16(kf, qf, p, 0, 0, 0);
                }
                const int qrel = qw + r32 - t0 - 4 * hi - 32 * kh;
                if (MODE == 0) {
                    if (diag) {
#pragma unroll
                        for (int r = 0; r < 16; ++r) { if ((r & 3) + 8 * (r >> 2) > qrel) p[r] = -INFINITY; } }
                    float rm = fmaxf(p[0], p[1]);
#pragma unroll
                    for (int r = 2; r < 16; ++r) rm = fmaxf(rm, p[r]);
                    { auto rr = __builtin_amdgcn_permlane32_swap(__float_as_uint(rm), __float_as_uint(rm), false, false); rm = fmaxf(__uint_as_float(rr[0]), __uint_as_float(rr[1])); }
                    if (__any(rm > mref[c] + THR)) {
                        const float mn = fmaxf(mref[c], rm); const float al = __builtin_amdgcn_exp2f(mref[c] - mn);
                        lsum[c] *= al; mref[c] = mn;
                        if (hi == 0) wsf[r32] = al;
                        LDS_WAIT();
#pragma unroll
                        for (int r = 0; r < 16; ++r) { const float a = wsf[crow(r, hi)];
#pragma unroll
                            for (int d = 0; d < 4; ++d) o[c][d][r] *= a; }
                        LDS_WAIT();
                    }
                    const float mm = mref[c]; float sacc = 0.f;
#pragma unroll
                    for (int r = 0; r < 16; ++r) { p[r] = __builtin_amdgcn_exp2f(p[r] - mm); sacc += p[r]; }
                    lsum[c] += sacc;
                } else {
                    const float rf = __builtin_amdgcn_exp2f(cg * (float)(qw + r32 - t0 - 32 * kh));
#pragma unroll
                    for (int r = 0; r < 16; ++r) { const float cf = __builtin_amdgcn_exp2f(-cg * (float)crow(r, hi)); p[r] = p[r] * (cf * rf); }
                    if (diag) {
#pragma unroll
                        for (int r = 0; r < 16; ++r) { if ((r & 3) + 8 * (r >> 2) > qrel) p[r] = 0.f; } }
                }
                v4u pa[2];
                pa[0] = (v4u){cvt_pk_bf16(p[0], p[1]), cvt_pk_bf16(p[2], p[3]), cvt_pk_bf16(p[4], p[5]), cvt_pk_bf16(p[6], p[7])};
                pa[1] = (v4u){cvt_pk_bf16(p[8], p[9]), cvt_pk_bf16(p[10], p[11]), cvt_pk_bf16(p[12], p[13]), cvt_pk_bf16(p[14], p[15])};
                { s16x4 va[4], vbq[4];
                  const int vad0 = (int)(uintptr_t)vb + (vbase ^ (0 << 6)) + kh * 8192, vad1 = (int)(uintptr_t)vb + (vbase ^ (1 << 6)) + kh * 8192;
                  const int vad2 = (int)(uintptr_t)vb + (vbase ^ (2 << 6)) + kh * 8192, vad3 = (int)(uintptr_t)vb + (vbase ^ (3 << 6)) + kh * 8192;
#define ATT_VRD(dst, ad) do { asm volatile("ds_read_b64_tr_b16 %0, %1" : "=v"(dst[0]) : "v"(ad) : "memory"); asm volatile("ds_read_b64_tr_b16 %0, %1 offset:2048" : "=v"(dst[1]) : "v"(ad) : "memory"); \
                                   asm volatile("ds_read_b64_tr_b16 %0, %1 offset:4096" : "=v"(dst[2]) : "v"(ad) : "memory"); asm volatile("ds_read_b64_tr_b16 %0, %1 offset:6144" : "=v"(dst[3]) : "v"(ad) : "memory"); } while (0)
#define ATT_VWAIT() do { asm volatile("s_waitcnt lgkmcnt(0)" ::: "memory"); __builtin_amdgcn_sched_barrier(0); } while (0)
#define ATT_PV(d, vv) do { o[c][d] = __builtin_amdgcn_mfma_f32_32x32x16_bf16(__builtin_bit_cast(bf16x8, pa[0]), ((bf16x8){vv[0][0], vv[0][1], vv[0][2], vv[0][3], vv[1][0], vv[1][1], vv[1][2], vv[1][3]}), o[c][d], 0, 0, 0); \
                                o[c][d] = __builtin_amdgcn_mfma_f32_32x32x16_bf16(__builtin_bit_cast(bf16x8, pa[1]), ((bf16x8){vv[2][0], vv[2][1], vv[2][2], vv[2][3], vv[3][0], vv[3][1], vv[3][2], vv[3][3]}), o[c][d], 0, 0, 0); } while (0)
                  __builtin_amdgcn_sched_barrier(0);
                  ATT_VRD(va, vad0); ATT_VWAIT();
                  ATT_VRD(vbq, vad1); __builtin_amdgcn_sched_barrier(0); ATT_PV(0, va); __builtin_amdgcn_sched_barrier(0); ATT_VWAIT();
                  ATT_VRD(va, vad2); __builtin_amdgcn_sched_barrier(0); ATT_PV(1, vbq); __builtin_amdgcn_sched_barrier(0); ATT_VWAIT();
                  ATT_VRD(vbq, vad3); __builtin_amdgcn_sched_barrier(0); ATT_PV(2, va); __builtin_amdgcn_sched_barrier(0); ATT_VWAIT();
                  ATT_PV(3, vbq); __builtin_amdgcn_sched_barrier(0);
#undef ATT_VRD
#undef ATT_VWAIT
#undef ATT_PV
                }
              }
            }
        }
        if (NBUF == 3 && staged) { if (bg_now) asm volatile("s_waitcnt vmcnt(11)" ::: "memory"); else asm volatile("s_waitcnt vmcnt(3)" ::: "memory"); }
        else { if (bg_now) asm volatile("s_waitcnt vmcnt(8)" ::: "memory"); else VM_WAIT(); }
#undef ATT_BGMID
        __syncthreads();
    }
    int lane_e = lane; asm volatile("" : "+v"(lane_e));
    LAS float* stg = (LAS float*)(lds + wid * STG_WAVE);
    { const int r32 = lane_e & 31, hi = lane_e >> 5;
      if (MODE == 0) {
        LAS float* wsf2 = (LAS float*)(lds + 8 * STG_WAVE) + wid * 64;
        float l0 = lsum[0], l1 = lsum[NMAP - 1];
        { auto rr = __builtin_amdgcn_permlane32_swap(__float_as_uint(l0), __float_as_uint(l0), false, false); l0 = __uint_as_float(rr[0]) + __uint_as_float(rr[1]); }
        { auto rr = __builtin_amdgcn_permlane32_swap(__float_as_uint(l1), __float_as_uint(l1), false, false); l1 = __uint_as_float(rr[0]) + __uint_as_float(rr[1]); }
        if (hi == 0) { wsf2[r32] = 1.0f / l0; wsf2[32 + r32] = -A.lam / l1; }
        LDS_WAIT();
#pragma unroll
        for (int r = 0; r < 16; ++r) { const float a0 = wsf2[crow(r, hi)], a1 = wsf2[32 + crow(r, hi)];
#pragma unroll
            for (int d = 0; d < 4; ++d) stg[crow(r, hi) * STG_PITCH + d * 32 + r32] = o[0][d][r] * a0 + o[NMAP - 1][d][r] * a1; }
      } else {
#pragma unroll
        for (int r = 0; r < 16; ++r)
#pragma unroll
            for (int d = 0; d < 4; ++d) stg[crow(r, hi) * STG_PITCH + d * 32 + r32] = o[0][d][r];
      }
    }
    LDS_WAIT();
    const int c8 = lane_e & 15;
#pragma unroll
    for (int ps = 0; ps < 8; ++ps) {
        const int row = 4 * ps + (lane_e >> 4);
        const f32x4 va = *(const LAS f32x4*)(stg + row * STG_PITCH + 8 * c8), vb4 = *(const LAS f32x4*)(stg + row * STG_PITCH + 8 * c8 + 4);
        float v[8] = {va[0], va[1], va[2], va[3], vb4[0], vb4[1], vb4[2], vb4[3]};
        const size_t tok = rowbase + qw + row;
        float ov[8];
        if (MODE == 0) {
            float ss = 0.f;
#pragma unroll
            for (int j = 0; j < 8; ++j) ss += v[j] * v[j];
            ss += __shfl_xor(ss, 1); ss += __shfl_xor(ss, 2); ss += __shfl_xor(ss, 4); ss += __shfl_xor(ss, 8);
            const float rn = 0.8f / sqrtf(ss * (1.0f / 128.0f) + EPS);
            const f32x4 g0 = *(const f32x4*)(A.subln_g + 8 * c8), g1 = *(const f32x4*)(A.subln_g + 8 * c8 + 4);
#pragma unroll
            for (int j = 0; j < 4; ++j) { ov[j] = v[j] * rn * g0[j]; ov[4 + j] = v[4 + j] * rn * g1[j]; }
        } else {
            float s1 = 0.f;
#pragma unroll
            for (int j = 0; j < 8; ++j) s1 += v[j];
            s1 += __shfl_xor(s1, 1); s1 += __shfl_xor(s1, 2); s1 += __shfl_xor(s1, 4); s1 += __shfl_xor(s1, 8);
            const float mu = s1 * (1.0f / 128.0f); float s2 = 0.f;
#pragma unroll
            for (int j = 0; j < 8; ++j) { v[j] -= mu; s2 += v[j] * v[j]; }
            s2 += __shfl_xor(s2, 1); s2 += __shfl_xor(s2, 2); s2 += __shfl_xor(s2, 4); s2 += __shfl_xor(s2, 8);
            const float rn = 1.0f / sqrtf(s2 * (1.0f / 128.0f) + EPS);
            const f32x4 g0 = *(const f32x4*)(A.gn_g + h * 128 + 8 * c8), g1 = *(const f32x4*)(A.gn_g + h * 128 + 8 * c8 + 4);
            const v4u gw = *(const v4u*)(A.proj + tok * NPROJ + C_RG + h * 128 + 8 * c8);
            float gt[8] = {bf2f(gw.x & 0xffff), bf2f(gw.x >> 16), bf2f(gw.y & 0xffff), bf2f(gw.y >> 16), bf2f(gw.z & 0xffff), bf2f(gw.z >> 16), bf2f(gw.w & 0xffff), bf2f(gw.w >> 16)};
#pragma unroll
            for (int j = 0; j < 8; ++j) { const float gg = (j < 4) ? g0[j] : g1[j - 4]; const float sl = gt[j] * __builtin_amdgcn_rcpf(1.0f + __builtin_amdgcn_exp2f(-gt[j] * LOG2E)); ov[j] = sl * (v[j] * rn * gg); }
        }
        v4u w; w.x = cvt_pk_bf16(ov[0], ov[1]); w.y = cvt_pk_bf16(ov[2], ov[3]); w.z = cvt_pk_bf16(ov[4], ov[5]); w.w = cvt_pk_bf16(ov[6], ov[7]);
        *(v4u*)(A.mix + tok * DM + (MODE == 0 ? 0 : 1024) + h * 128 + 8 * c8) = w;
    }
    LDS_WAIT(); __syncthreads();
}
#undef ATT_STAGE
#undef ATT_SRC
}

#define XB_TMO      128
#define XB_XCNT(j)  (256  + 64 * (j))
#define XB_XSUB(j)  (1280 + 64 * (j))
#define XB_XGEN(j)  (2304 + 64 * (j))
#define XB_TOP      3328
#define XB_TOPGEN   3392
#define XCD_BAR_WORDS 3456
#define XB_SPIN_CAP (1u << 18)
__device__ __forceinline__ unsigned xb_ld(unsigned* p)              { return __hip_atomic_load(p, __ATOMIC_RELAXED, __HIP_MEMORY_SCOPE_AGENT); }
__device__ __forceinline__ unsigned xb_add(unsigned* p, unsigned v) { return __hip_atomic_fetch_add(p, v, __ATOMIC_RELAXED, __HIP_MEMORY_SCOPE_AGENT); }
__device__ __forceinline__ unsigned xb_xcc_id() { return (unsigned)__builtin_amdgcn_s_getreg((3 << 11) | 20) & 0xFu; }
#define XB_SPIN(cond, bar) do { unsigned _sp = 0; while (cond) { __builtin_amdgcn_s_sleep(1); \
    if ((++_sp & 255u) == 0u) { if (xb_ld(&(bar)[XB_TMO])) break; if (_sp > XB_SPIN_CAP) { atomicAdd(&(bar)[XB_TMO], 1u); break; } } } } while (0)
struct XcdBarrier { unsigned* bar; unsigned x; volatile LAS unsigned* st; };
__device__ __forceinline__ XcdBarrier xcd_barrier_post(unsigned* bar, volatile LAS unsigned* st) {
    XcdBarrier b; b.bar = bar; b.x = xb_xcc_id(); b.st = st;
    if (threadIdx.x == 0) (void)xb_add(&bar[XB_XCNT(b.x)], 1u);
    return b;
}
__device__ __forceinline__ void xcd_barrier_complete(unsigned* bar, unsigned x, unsigned& nloc, unsigned& nx) {
    const unsigned G = gridDim.x * gridDim.y * gridDim.z;
    unsigned sum, cnt, mine, sp = 0u;
    for (;;) {
        sum = 0u; cnt = 0u; mine = 0u;
#pragma unroll
        for (unsigned j = 0; j < 16; ++j) { const unsigned c = xb_ld(&bar[XB_XCNT(j)]); sum += c; cnt += (c > 0u) ? 1u : 0u; mine = (j == x) ? c : mine; }
        if (sum == G) break;
        __builtin_amdgcn_s_sleep(1);
        if ((++sp & 255u) == 0u) { if (xb_ld(&bar[XB_TMO])) break; if (sp > XB_SPIN_CAP) { atomicAdd(&bar[XB_TMO], 1u); break; } }
    }
    nloc = mine > 0u ? mine : 1u; nx = cnt > 0u ? cnt : 1u;
}
__device__ __forceinline__ void xcd_barrier(const XcdBarrier& b) {
    asm volatile("s_waitcnt vmcnt(0)" ::: "memory");
    __syncthreads();
    if (threadIdx.x == 0) {
        unsigned* bar = b.bar;
        __builtin_amdgcn_s_waitcnt(0);
        unsigned nloc = b.st[0], nx = b.st[1];
        if (nloc == 0u) { xcd_barrier_complete(bar, b.x, nloc, nx); b.st[0] = nloc; b.st[1] = nx; }
        const unsigned old = xb_add(&bar[XB_XSUB(b.x)], 1u);
        const unsigned gen = old / nloc;
        if (old + 1u == (gen + 1u) * nloc) {
            __builtin_amdgcn_fence(__ATOMIC_RELEASE, "agent");
            asm volatile("s_waitcnt vmcnt(0)" ::: "memory");
            const unsigned og = xb_add(&bar[XB_TOP], 1u);
            const unsigned tg = og / nx;
            if (og + 1u == (tg + 1u) * nx) xb_add(&bar[XB_TOPGEN], 1u);
            else XB_SPIN(xb_ld(&bar[XB_TOPGEN]) == tg, bar);
            __builtin_amdgcn_fence(__ATOMIC_ACQUIRE, "agent");
            xb_add(&bar[XB_XGEN(b.x)], 1u);
            asm volatile("s_waitcnt vmcnt(0)" ::: "memory");
        } else {
            XB_SPIN(xb_ld(&bar[XB_XGEN(b.x)]) == gen, bar);
            __builtin_amdgcn_fence(__ATOMIC_ACQUIRE, "agent");
            asm volatile("s_waitcnt vmcnt(0)" ::: "memory");
        }
    }
    __syncthreads();
}

template <int MODE>
__device__ __forceinline__ int dest_row(int n) {
    if (MODE == 1) { if (n >= C_RQ && n < C_RV) { const int i = n & 63; return (n & ~63) + 2 * (i & 31) + (i >> 5); } return n; }
    if (MODE == 2) return 8 * (n >> 2) + (n & 3);
    if (MODE == 3) return 8 * (n >> 2) + 4 + (n & 3);
    return n;
}
template <int MODE>
__device__ __forceinline__ void p0_transpose_item(const float* W, int K, int N, bf16* WT, LAS float* scr, int item, int lane) {
    const int nblk = N / 32, kb = item / nblk, nb = item % nblk, k0 = 64 * kb, n0 = 32 * nb;
    float wv[32];
#pragma unroll
    for (int i = 0; i < 32; ++i) { const int kk = 2 * i + (lane >> 5); wv[i] = W[(size_t)(k0 + kk) * N + n0 + (lane & 31)]; }
#pragma unroll
    for (int i = 0; i < 32; ++i) { const int kk = 2 * i + (lane >> 5); scr[kk * 33 + (lane & 31)] = wv[i]; }
    LDS_WAIT(); asm volatile("" ::: "memory");
    const int c = lane & 7;
#pragma unroll
    for (int j = 0; j < 4; ++j) { const int n = (lane >> 3) + 8 * j; const LAS float* s = scr + (8 * c) * 33 + n;
        v4u o; o.x = pk2(s[0 * 33], s[1 * 33]); o.y = pk2(s[2 * 33], s[3 * 33]); o.z = pk2(s[4 * 33], s[5 * 33]); o.w = pk2(s[6 * 33], s[7 * 33]);
        *(GAS v4u*)(WT + (size_t)dest_row<MODE>(n0 + n) * K + k0 + 8 * c) = o; }
    LDS_WAIT(); asm volatile("" ::: "memory");
}

template <int MODE>
__device__ __forceinline__ void p0_direct_item(const float* W, int K, int N, bf16* WT, int item, int lane) {
    const int nblk = N / 32, kb = item / nblk, nb = item % nblk, n4 = lane & 7, kr = lane >> 3, k0 = 64 * kb + 8 * kr, n0 = 32 * nb + 4 * n4;
    const float* src = W + (size_t)k0 * N + n0;
    f32x4 r[8];
#pragma unroll
    for (int j = 0; j < 8; ++j) r[j] = *(const f32x4*)(src + (size_t)j * N);
#pragma unroll
    for (int i = 0; i < 4; ++i) { v4u w; w.x = pk2(r[0][i], r[1][i]); w.y = pk2(r[2][i], r[3][i]); w.z = pk2(r[4][i], r[5][i]); w.w = pk2(r[6][i], r[7][i]);
        *(GAS v4u*)(WT + (size_t)dest_row<MODE>(n0 + i) * K + k0) = w; }
}

struct KArgs { const float* in[20]; float* out; unsigned char* ws; int ph_lo, ph_hi; };

__global__ void __launch_bounds__(512, 2) hymba_fwd(KArgs args) {
    extern __shared__ __attribute__((aligned(16))) unsigned char lds_raw[];
    LAS unsigned char* lds = (LAS unsigned char*)lds_raw;
    volatile LAS unsigned* MISC = (volatile LAS unsigned*)(lds + MISC_OFF);
    LAS int* LTAB = (LAS int*)(lds + LTAB_OFF);
    const int tid = threadIdx.x, lane = tid & 63, wave = __builtin_amdgcn_readfirstlane(tid >> 6);
    const int G = gridDim.x; const int vcu = (G % 8 == 0) ? ((int)blockIdx.x % 8) * (G / 8) + (int)blockIdx.x / 8 : (int)blockIdx.x;
    const int gw = vcu * 8 + wave, NGW = G * 8;
    unsigned char* ws = args.ws;
    gu32* ctl = (gu32*)(ws + WS_CTL);
    const float* x = args.in[0]; const float* rel_bias = args.in[1]; const float* attn_norm_g = args.in[2]; const float* w_in = args.in[3];
    const float* lq1 = args.in[4]; const float* lk1 = args.in[5]; const float* lq2 = args.in[6]; const float* lk2 = args.in[7];
    const float* subln_g = args.in[8]; const float* gn_g = args.in[9]; const float* w_out = args.in[10]; const float* ffn_norm_g = args.in[11];
    const float* w_gr = args.in[12]; const float* b_group = args.in[13]; const float* w_ir = args.in[14]; const float* b_inner = args.in[15];
    const float* w_gate = args.in[16]; const float* w_up = args.in[17]; const float* w_down = args.in[18]; const float* final_g = args.in[19];
    float* out = args.out;
    f32x2* rope = (f32x2*)(ws + WS_ROPE); float* tbw = (float*)(ws + WS_TB);
    bf16* WRH = (bf16*)(ws + WS_WRH); bf16* WRL = (bf16*)(ws + WS_WRL);
    int* tok_e = (int*)(ws + WS_TOK + TOK_E); int* tok_rank = (int*)(ws + WS_TOK + TOK_RANK); float* irs1 = (float*)(ws + WS_TOK + TOK_GATE);
    float* tok_rs2 = (float*)(ws + WS_TOK + TOK_RS2); int* tok_pos = (int*)(ws + WS_TOK + TOK_POS); float* row_gate = (float*)(ws + WS_TOK + ROW_GATE);
    int* lst_tok = (int*)(ws + WS_LST); float* lst_rs = (float*)(ws + WS_LST + 2 * MiB); float* lst_gate = (float*)(ws + WS_LST + 4 * MiB);
    bf16* BTIN = (bf16*)(ws + WS_BTIN); bf16* BTOUT = (bf16*)(ws + WS_BTOUT); unsigned char* BTGU = ws + WS_BTGU; unsigned char* BTD = ws + WS_BTD;
    bf16* XN = (bf16*)(ws + WS_XN); bf16* MIX = (bf16*)(ws + WS_MIX); unsigned char* ACT = ws + WS_ACT;
    bf16* PROJ = (bf16*)(ws + WS_PROJ); unsigned char* XG = ws + WS_XG; unsigned char* Y = ws + WS_Y;
    bf16* X1 = (bf16*)(ws + WS_X1);

    for (int u = tid; u < (LDS_BYTES - LDSCTL_OFF) / 4; u += 512) ((LAS unsigned*)(lds + LDSCTL_OFF))[u] = 0u;
    __syncthreads();
    XcdBarrier bar; bar.bar = (unsigned*)(ctl + CW_BAR); bar.x = 0; bar.st = nullptr;
    if (N_LAUNCHES == 1) bar = xcd_barrier_post((unsigned*)(ctl + CW_BAR), MISC + 8);
    const int lo = args.ph_lo, hi_ph = args.ph_hi;
#ifndef PHASE_MASK
#define PHASE_MASK 0x1ff
#endif
#define IN(k) (((PHASE_MASK >> (k)) & 1) && lo <= (k) && (k) < hi_ph)
#ifndef PROBE_DUP
#define PROBE_DUP 0
#endif
#define REP(k) ((((PROBE_DUP) >> (k)) & 1) ? 2 : 1)
#define GRID_BAR(k) do { if (IN(k) && IN((k) + 1)) xcd_barrier(bar); } while (0)

    for (int rep_ = 0; rep_ < REP(0); ++rep_) if (IN(0)) {
        LAS float* scr = (LAS float*)(lds + RING_OFF + wave * 16384);
        constexpr int I_IN = (DM / 64) * (NPROJ / 32), I_OUT = (DM / 64) * (DM / 32);
        constexpr int NITEMS = I_IN + I_OUT;
        static_assert(BG_MODE == 3, "the expert weights are converted in the background of P2 only");
        for (int it = gw; it < NITEMS; it += NGW) {
            int r = it;
            if (r < I_IN) { p0_direct_item<1>(w_in, DM, NPROJ, BTIN, r, lane); continue; } r -= I_IN;
            p0_direct_item<0>(w_out, DM, DM, BTOUT, r, lane);
        }
        { const GAS f32x4* gr = (const GAS f32x4*)attn_norm_g + lane;
          f32x4 nx[8];
          if (gw < NTOK) { const GAS f32x4* xr = (const GAS f32x4*)(x + (size_t)gw * DM) + lane;
#pragma unroll
              for (int j = 0; j < 8; ++j) nx[j] = xr[64 * j]; }
          for (int m = gw; m < NTOK; m += NGW) {
            f32x4 v[8]; float s = 0.f;
#pragma unroll
            for (int j = 0; j < 8; ++j) { v[j] = nx[j]; s += (v[j].x * v[j].x + v[j].y * v[j].y) + (v[j].z * v[j].z + v[j].w * v[j].w); }
            if (m + NGW < NTOK) { const GAS f32x4* xr = (const GAS f32x4*)(x + (size_t)(m + NGW) * DM) + lane;
#pragma unroll
                for (int j = 0; j < 8; ++j) nx[j] = xr[64 * j]; }
            const float srt = sqrtf(wave_sum(s) * (1.0f / DM) + EPS), rs = 1.0f / srt;
            if (lane == 0) irs1[m] = srt;
            GAS unsigned long long* o8 = (GAS unsigned long long*)(XN + (size_t)m * DM) + lane;
#pragma unroll
            for (int j = 0; j < 8; ++j) { const f32x4 g = gr[64 * j]; o8[64 * j] = (unsigned long long)pk2(v[j].x * rs * g.x, v[j].y * rs * g.y) | ((unsigned long long)pk2(v[j].z * rs * g.z, v[j].w * rs * g.w) << 32); }
          }
        }
        for (int i = blockIdx.x * 512 + tid; i < SEQ * 32; i += G * 512) { const int pos = i >> 5, t = i & 31;
            const float f = __builtin_amdgcn_exp2f(-(float)t * (13.287712379549449f / 32.0f));
            double rev = (double)((float)pos * f) * 0.15915494309189535; rev -= __builtin_rint(rev);
            rope[i] = (f32x2){__builtin_amdgcn_cosf((float)rev), __builtin_amdgcn_sinf((float)rev)}; }
        for (int i = blockIdx.x * 512 + tid; i < 8 * 304; i += G * 512) { const int hh = i / 304, d = 207 - (i % 304); int bkt;
            if (d < 16) bkt = d < 0 ? 0 : d; else { const float lr = __logf((float)d / 16.0f) / 2.0794415416798357f; bkt = 16 + (int)(lr * 16.0f); bkt = bkt > 31 ? 31 : bkt; }
            tbw[i] = rel_bias[bkt * 8 + hh] * LOG2E; }
        for (int i = blockIdx.x * 512 + tid; i < 48 * DM; i += G * 512) { const int c = i / DM, k = i % DM; float w = 0.f;
            if (c < 4) w = w_gr[k * 4 + c]; else if (c < 36) { const int gq = (c - 4) >> 3, e = (c - 4) & 7; w = w_ir[((size_t)gq * DM + k) * 8 + e]; }
            const unsigned hb = f2bf(w); WRH[i] = (bf16)hb; WRL[i] = (bf16)f2bf(w - bf2f((unsigned short)hb)); }
    }
    GRID_BAR(0);

    if (IN(1)) {
        pg8::Gemm g{XN, BTIN, DM * 2, 0, nullptr}; pg8::StaticOrder S; S.init(NTOK, NPROJ, G, (int)blockIdx.x, REP(1));
        pg8::EpiProj E{PROJ, rope};
        pg8::gemm_phase<pg8::EpiProj, pg8::StaticOrder>(lds + RING_OFF, g, S, E);
    }
    GRID_BAR(1);

    if (IN(2)) {
        float s1 = 0.f, s2 = 0.f;
        if (lane < 64) { s1 = lq1[lane] * lk1[lane]; s2 = lq2[lane] * lk2[lane]; }
        s1 = wave_sum(s1); s2 = wave_sum(s2);
        const float lam = __expf(s1) - __expf(s2) + 0.2f;
        att::Args A{PROJ, MIX, tbw, subln_g, gn_g, lam};
        att::Bg BG; BG.wg = w_gate; BG.wu = w_up; BG.wd = w_down; BG.btgu = BTGU; BG.btd = BTD; BG.have = false;
        { constexpr int NBG = NEXP * 3 * 1024; const int per = (NBG + NGW - 1) / NGW; BG.it = gw * per; BG.end = BG.it + per < NBG ? BG.it + per : NBG; if (BG.it > NBG) BG.it = NBG; }
#pragma unroll
        for (int j = 0; j < 8; ++j) BG.r[j] = (f32x4){0.f, 0.f, 0.f, 0.f};
        for (int it0 = vcu; it0 < 256 * REP(2); it0 += G) { const int it = it0 & 255;
            const int bh = it >> 2, s = it & 3, b = bh >> 3, h = bh & 7;
            for (int i = 0; i < 2; ++i) { const int qb = i ? s : 7 - s;
#ifndef NO_M0
                att::attn_unit<0>(A, BG, b, h, qb, lds);
#endif
#ifndef NO_M1
                att::attn_unit<1>(A, BG, b, h, qb, lds);
#endif
            }
        }
        for (;;) { att::bg_retire(BG, lane); if (BG.it >= BG.end) break; att::bg_issue(BG, lane); }
    }
    GRID_BAR(2);

    if (IN(3)) {
        pg8::Gemm g{MIX, BTOUT, DM * 2, 0, nullptr}; pg8::StaticOrder S; S.init(NTOK, DM, G, (int)blockIdx.x, REP(3));
        pg8::EpiRes E{XN, irs1, attn_norm_g, X1, XG, ffn_norm_g};
        pg8::gemm_phase<pg8::EpiRes, pg8::StaticOrder>(lds + RING_OFF, g, S, E);
    }
    GRID_BAR(3);

    if (IN(4)) {
        LAS float* lgp = (LAS float*)(lds + RING_OFF) + (wave >> 1) * 2048;
        const int r = lane & 15, q4 = lane >> 4, kh = wave & 1;
        for (int tile = gw >> 1; tile < NTOK / 16; tile += NGW / 2) {
            const int t0 = tile * 16;
            f32x4 acc[3]; float ss;
            for (int rep4_ = 0; rep4_ < REP(4); ++rep4_) {
            acc[0] = (f32x4){0.f, 0.f, 0.f, 0.f}; acc[1] = acc[0]; acc[2] = acc[0]; ss = 0.f;
            const bf16* xrow = X1 + (size_t)(t0 + r) * DM + kh * 1024 + 8 * q4;
            const float* grow = ffn_norm_g + kh * 1024 + 8 * q4;
            const bf16* wh = WRH + (size_t)r * DM + kh * 1024 + 8 * q4; const bf16* wl = WRL + (size_t)r * DM + kh * 1024 + 8 * q4;
#pragma unroll 8
            for (int k0 = 0; k0 < 1024; k0 += 32) {
                const v4u xw = *(const v4u*)(xrow + k0);
                const f32x4 xa = (f32x4){bf2f(xw.x & 0xffff), bf2f(xw.x >> 16), bf2f(xw.y & 0xffff), bf2f(xw.y >> 16)}, xb = (f32x4){bf2f(xw.z & 0xffff), bf2f(xw.z >> 16), bf2f(xw.w & 0xffff), bf2f(xw.w >> 16)};
                const f32x4 ga = *(const f32x4*)(grow + k0), gb = *(const f32x4*)(grow + k0 + 4);
                float hv[8] = {xa[0] * ga[0], xa[1] * ga[1], xa[2] * ga[2], xa[3] * ga[3], xb[0] * gb[0], xb[1] * gb[1], xb[2] * gb[2], xb[3] * gb[3]};
                ss += (xa[0] * xa[0] + xa[1] * xa[1]) + (xa[2] * xa[2] + xa[3] * xa[3]) + (xb[0] * xb[0] + xb[1] * xb[1]) + (xb[2] * xb[2] + xb[3] * xb[3]);
                unsigned hb[8], lb[8];
#pragma unroll
                for (int j = 0; j < 8; ++j) { hb[j] = f2bf(hv[j]); lb[j] = f2bf(hv[j] - bf2f((unsigned short)hb[j])); }
                const v4u ahw = (v4u){hb[0] | (hb[1] << 16), hb[2] | (hb[3] << 16), hb[4] | (hb[5] << 16), hb[6] | (hb[7] << 16)};
                const v4u alw = (v4u){lb[0] | (lb[1] << 16), lb[2] | (lb[3] << 16), lb[4] | (lb[5] << 16), lb[6] | (lb[7] << 16)};
                const bf16x8 ah = __builtin_bit_cast(bf16x8, ahw), al = __builtin_bit_cast(bf16x8, alw);
#pragma unroll
                for (int cb = 0; cb < 3; ++cb) {
                    const bf16x8 bh = *(const bf16x8*)(wh + (size_t)cb * 16 * DM + k0), bl = *(const bf16x8*)(wl + (size_t)cb * 16 * DM + k0);
                    acc[cb] = __builtin_amdgcn_mfma_f32_16x16x32_bf16(ah, bh, acc[cb], 0, 0, 0);
                    acc[cb] = __builtin_amdgcn_mfma_f32_16x16x32_bf16(al, bh, acc[cb], 0, 0, 0);
                    acc[cb] = __builtin_amdgcn_mfma_f32_16x16x32_bf16(ah, bl, acc[cb], 0, 0, 0);
                }
            }
            }
            ss += __shfl_xor(ss, 16); ss += __shfl_xor(ss, 32);
            if (kh == 1) {
#pragma unroll
                for (int cb = 0; cb < 3; ++cb)
#pragma unroll
                    for (int i = 0; i < 4; ++i) lgp[1024 + lane * 13 + cb * 4 + i] = acc[cb][i];
                lgp[1024 + lane * 13 + 12] = ss;
            }
            __syncthreads();
            if (kh == 0) {
#pragma unroll
                for (int cb = 0; cb < 3; ++cb)
#pragma unroll
                    for (int i = 0; i < 4; ++i) lgp[(4 * q4 + i) * 48 + cb * 16 + r] = acc[cb][i] + lgp[1024 + lane * 13 + cb * 4 + i];
                ss += lgp[1024 + lane * 13 + 12];
                const float rs2 = 1.0f / sqrtf(ss * (1.0f / DM) + EPS);
                LDS_WAIT(); asm volatile("" ::: "memory");
                if (lane < 16) {
                    const LAS float* L = lgp + lane * 48; const int tok = t0 + lane;
                    float gl[4]; int gi = 0; float gmx = -INFINITY;
#pragma unroll
                    for (int g = 0; g < 4; ++g) { gl[g] = rs2 * L[g] + b_group[g]; if (gl[g] > gmx) { gmx = gl[g]; gi = g; } }
                    float den = 0.f;
#pragma unroll
                    for (int g = 0; g < 4; ++g) den += __expf(gl[g] - gmx);
                    const float pg = 1.0f / den;
                    int i0 = 0, i1 = 0; float v0 = -INFINITY, v1 = -INFINITY;
#pragma unroll
                    for (int e = 0; e < 8; ++e) { const float v = rs2 * L[4 + 8 * gi + e] + b_inner[gi * 8 + e]; if (v > v0) { v1 = v0; i1 = i0; v0 = v; i0 = e; } else if (v > v1) { v1 = v; i1 = e; } }
                    const float w0 = 1.0f / (1.0f + __expf(v1 - v0)), w1 = 1.0f - w0;
                    const int e0 = 8 * gi + i0, e1 = 8 * gi + i1;
                    const int rk0 = (int)__hip_atomic_fetch_add((unsigned*)(ctl + CW_CNT + 16 * e0), 1u, RLX_AGENT);
                    const int rk1 = (int)__hip_atomic_fetch_add((unsigned*)(ctl + CW_CNT + 16 * e1), 1u, RLX_AGENT);
                    tok_e[2 * tok] = e0; tok_e[2 * tok + 1] = e1; tok_rank[2 * tok] = rk0; tok_rank[2 * tok + 1] = rk1;
                    lst_tok[e0 * pg8::LCAP + rk0] = tok; lst_rs[e0 * pg8::LCAP + rk0] = rs2; lst_gate[e0 * pg8::LCAP + rk0] = pg * w0;
                    lst_tok[e1 * pg8::LCAP + rk1] = tok; lst_rs[e1 * pg8::LCAP + rk1] = rs2; lst_gate[e1 * pg8::LCAP + rk1] = pg * w1;
                }
            }
            LDS_WAIT(); __syncthreads();
        }
    }
    GRID_BAR(4);

    if (IN(6) || IN(7) || IN(8)) {
        if (tid == 0) { int off = 0, nt = 0;
            for (int e = 0; e < NEXP; ++e) { const int c = (int)__hip_atomic_load((unsigned*)(ctl + CW_CNT + 16 * e), RLX_AGENT); const int pc = (c + 255) >> 8;
                LTAB[e] = off; LTAB[96 + e] = c; for (int i = 0; i < pc; ++i) LTAB[128 + nt + i] = e; nt += pc; off += pc * 256; }
            LTAB[32] = nt; }
        __syncthreads();
    }
    {
        const int U = LTAB[32] * 8, R = U / G, rem = U - R * G, E = G - rem;
        const bool mixed = (FORCE_NOMIX == 0) && (N_LAUNCHES == 1) && IN(6) && IN(7) && R >= 1 && rem > 0 && 2 * rem <= G && (PROBE_DUP & 0xC0) == 0;
        const pg8::Gemm g6{XG, BTGU, DM, (size_t)2048 * DM, lst_tok}; const pg8::EpiSwiglu E6{ACT, lst_rs};
        const pg8::Gemm g7{ACT, BTD, FF, (size_t)DM * FF, nullptr}; const pg8::EpiDown E7{Y, lst_gate};
        if (mixed) {
            { pg8::GroupOrder S{LTAB[32], 8, G, vcu, LTAB, 0, R * G}; pg8::gemm_phase<pg8::EpiSwiglu, pg8::GroupOrder, true, true, 122, 127>(lds + RING_OFF, g6, S, E6); }
            xcd_barrier(bar);
            if (vcu < rem) { pg8::GroupOrder S{LTAB[32], 8, G, vcu, LTAB, R * G, U}; pg8::gemm_phase<pg8::EpiSwiglu, pg8::GroupOrder, true, true, 122, 127>(lds + RING_OFF, g6, S, E6); }
            else { pg8::GroupOrder S{LTAB[32], 8, G, vcu, LTAB, -rem, E}; pg8::gemm_phase<pg8::EpiDown, pg8::GroupOrder, false, true, 122, 127>(lds + RING_OFF, g7, S, E7); }
            xcd_barrier(bar);
            { pg8::GroupOrder S{LTAB[32], 8, G, vcu, LTAB, E, U}; pg8::gemm_phase<pg8::EpiDown, pg8::GroupOrder, false, true, 122, 127>(lds + RING_OFF, g7, S, E7); }
        } else {
            for (int rep_ = 0; rep_ < REP(6); ++rep_) if (IN(6)) { pg8::GroupOrder S{LTAB[32], 8, G, vcu, LTAB, 0, U}; pg8::gemm_phase<pg8::EpiSwiglu, pg8::GroupOrder, true, true, 122, 127>(lds + RING_OFF, g6, S, E6); }
            GRID_BAR(6);
            for (int rep_ = 0; rep_ < REP(7); ++rep_) if (IN(7)) { pg8::GroupOrder S{LTAB[32], 8, G, vcu, LTAB, 0, U}; pg8::gemm_phase<pg8::EpiDown, pg8::GroupOrder, false, true, 122, 127>(lds + RING_OFF, g7, S, E7); }
        }
    }
    GRID_BAR(7);

    for (int rep_ = 0; rep_ < REP(8); ++rep_) if (IN(8)) {
        unsigned poison = (__hip_atomic_load(ctl + CW_BAR + XB_TMO, RLX_AGENT) != 0u);
        int myd0 = 0, myd1 = 0;
        { const int m = gw + lane * NGW; if (m < NTOK) { myd0 = LTAB[tok_e[2 * m]] + tok_rank[2 * m]; myd1 = LTAB[tok_e[2 * m + 1]] + tok_rank[2 * m + 1]; } }
        const GAS f32x4* gr = (const GAS f32x4*)final_g + lane;
        v2u xv[8]; unsigned ya[8], yc[8];
#define P8_LOAD(i_) do { const int m_ = gw + (i_) * NGW; const int d0_ = __shfl(myd0, (i_)), d1_ = __shfl(myd1, (i_)); \
            const GAS v2u* xr_ = (const GAS v2u*)(X1 + (size_t)m_ * DM) + lane; const GAS unsigned* y0_ = (const GAS unsigned*)(Y + (size_t)d0_ * DM) + lane; const GAS unsigned* y1_ = (const GAS unsigned*)(Y + (size_t)d1_ * DM) + lane; \
            _Pragma("unroll") for (int j = 0; j < 8; ++j) { xv[j] = xr_[64 * j]; ya[j] = y0_[64 * j]; yc[j] = y1_[64 * j]; } } while (0)
        if (gw < NTOK) P8_LOAD(0);
        for (int i = 0, m = gw; m < NTOK; m += NGW, ++i) {
            f32x4 v[8]; float s = 0.f;
#pragma unroll
            for (int j = 0; j < 8; ++j) { const int a = (int)ya[j], c = (int)yc[j]; constexpr float iy = 1.0f / YSCALE;
                v[j].x = bf2f(xv[j].x & 0xffff) + (__builtin_amdgcn_cvt_f32_fp8(a, 0) + __builtin_amdgcn_cvt_f32_fp8(c, 0)) * iy; v[j].y = bf2f(xv[j].x >> 16) + (__builtin_amdgcn_cvt_f32_fp8(a, 1) + __builtin_amdgcn_cvt_f32_fp8(c, 1)) * iy;
                v[j].z = bf2f(xv[j].y & 0xffff) + (__builtin_amdgcn_cvt_f32_fp8(a, 2) + __builtin_amdgcn_cvt_f32_fp8(c, 2)) * iy; v[j].w = bf2f(xv[j].y >> 16) + (__builtin_amdgcn_cvt_f32_fp8(a, 3) + __builtin_amdgcn_cvt_f32_fp8(c, 3)) * iy;
                s += (v[j].x * v[j].x + v[j].y * v[j].y) + (v[j].z * v[j].z + v[j].w * v[j].w); }
            if (m + NGW < NTOK) P8_LOAD(i + 1);
            float rs = 1.0f / sqrtf(wave_sum(s) * (1.0f / DM) + EPS);
            if (poison) rs = __builtin_nanf("");
            GAS f32x4* orow = (GAS f32x4*)(out + (size_t)m * DM) + lane;
#pragma unroll
            for (int j = 0; j < 8; ++j) { const f32x4 g = gr[64 * j]; orow[64 * j] = (f32x4){v[j].x * rs * g.x, v[j].y * rs * g.y, v[j].z * rs * g.z, v[j].w * rs * g.w}; }
        }
#undef P8_LOAD
    }
#undef IN
#undef GRID_BAR
}

extern "C" void kernel_launch(void* const* d_in, const int* in_sizes, int n_in, void* d_out, int out_size, void* d_ws, size_t ws_size, hipStream_t stream) {
    static int grid = 0;
    if (grid == 0) {
        if (n_in != 20 || in_sizes[0] != NTOK * DM || out_size != NTOK * DM || ws_size < WS_END) {
            fprintf(stderr, "kernel_launch: unexpected shapes: n_in %d in0 %d out %d ws %zu (need %zu); nothing launched\n", n_in, n_in > 0 ? in_sizes[0] : -1, out_size, ws_size, (size_t)WS_END); grid = -1; return; }
        int dev = 0, cus = 0, per_cu = 0;
        if (hipGetDevice(&dev) != hipSuccess || hipDeviceGetAttribute(&cus, hipDeviceAttributeMultiprocessorCount, dev) != hipSuccess) { fprintf(stderr, "kernel_launch: device query failed\n"); grid = -1; return; }
        if (hipFuncSetAttribute((const void*)hymba_fwd, hipFuncAttributeMaxDynamicSharedMemorySize, LDS_BYTES) != hipSuccess) { fprintf(stderr, "kernel_launch: hipFuncSetAttribute failed\n"); grid = -1; return; }
        if (hipOccupancyMaxActiveBlocksPerMultiprocessor(&per_cu, (const void*)hymba_fwd, 512, LDS_BYTES) != hipSuccess || per_cu < 1) {
            fprintf(stderr, "kernel_launch: occupancy query reports %d workgroups per CU\n", per_cu); per_cu = 1; }
        (void)hipGetLastError();
        grid = cus;
    }
    if (grid < 0) return;
    if (hipMemsetAsync((char*)d_ws + WS_CTL, 0, CTL_ZERO_BYTES, stream) != hipSuccess) { fprintf(stderr, "kernel_launch: memset failed\n"); return; }
    KArgs a{};
    for (int i = 0; i < 20; ++i) a.in[i] = (const float*)d_in[i];
    a.out = (float*)d_out; a.ws = (unsigned char*)d_ws;
    for (int li = 0; li < N_LAUNCHES; ++li) {
        a.ph_lo = (N_LAUNCHES == 1) ? 0 : li; a.ph_hi = (N_LAUNCHES == 1) ? N_PHASES : li + 1;
        hipLaunchKernelGGL(hymba_fwd, dim3(grid), dim3(512), LDS_BYTES, stream, a);
        const hipError_t le = hipPeekAtLastError();
        if (le != hipSuccess) { fprintf(stderr, "kernel_launch: launch %d failed: %s\n", li, hipGetErrorName(le)); break; }
    }
}
```

```cpp
#include <hip/hip_runtime.h>
#include <cstdio>
#include <cstdint>
#include <type_traits>

#ifndef BG_MODE
#define BG_MODE 3
#endif
#ifndef FORCE_NOMIX
#define FORCE_NOMIX 0
#endif
#ifndef MK_N_LAUNCHES
#define MK_N_LAUNCHES 1
#endif
constexpr int N_PHASES = 9;
constexpr int N_LAUNCHES = MK_N_LAUNCHES;

constexpr int BATCH = 8, SEQ = 2048, DM = 2048, NTOK = BATCH * SEQ;
constexpr int NPROJ = 6144;
constexpr int C_DQ = 0, C_DK = 1024, C_DV = 2048, C_RQ = 3072, C_RK = 3584, C_RV = 4096, C_RG = 5120;
constexpr int NEXP = 32, FF = 1024;
constexpr int XS_ROWS = 40960;
constexpr float EPS = 1e-6f;
constexpr float LOG2E = 1.4426950408889634f;
constexpr float YSCALE = 16.0f;
constexpr float QSCALE = 0.125f * LOG2E;

constexpr size_t MiB = 1u << 20;
constexpr size_t WS_CTL = 0, CTL_ZERO_BYTES = 1 * MiB;
constexpr size_t WS_ROPE = 1 * MiB;
constexpr size_t WS_TB = 1 * MiB + 512 * 1024;
constexpr size_t WS_WRH = 2 * MiB, WS_WRL = 2 * MiB + 256 * 1024;
constexpr size_t WS_TOK = 3 * MiB;
constexpr size_t TOK_E = 0, TOK_RANK = 128 * 1024, TOK_GATE = 256 * 1024, TOK_RS2 = 384 * 1024, TOK_POS = 448 * 1024, ROW_GATE = 576 * 1024, ROW_RS = 736 * 1024;
constexpr size_t WS_SROW = 2 * MiB + 512 * 1024;
constexpr size_t WS_BTIN = 4 * MiB, WS_BTOUT = 28 * MiB, WS_BTGU = 36 * MiB, WS_BTD = 292 * MiB;
constexpr size_t WS_XN = 420 * MiB, WS_MIX = 484 * MiB, WS_ACT = 420 * MiB;
constexpr size_t WS_PROJ = 548 * MiB, WS_Y = 548 * MiB, WS_XG = 708 * MiB;
constexpr size_t WS_X1 = 772 * MiB, WS_LST = 840 * MiB, WS_END = 900 * MiB;
constexpr int CW_TMO = 0, CW_CODE = 1, CW_BAR = 4096, CW_CNT = 16384;

constexpr int RING_OFF = 0, RING_BYTES = 131072;
constexpr int LDSCTL_OFF = 139264, MISC_OFF = LDSCTL_OFF + 320;
constexpr int LTAB_OFF = LDSCTL_OFF + 1024;
constexpr int LDS_BYTES = 147456;

#define GAS __attribute__((address_space(1)))
#define LAS __attribute__((address_space(3)))
typedef unsigned short bf16;
typedef unsigned v4u __attribute__((ext_vector_type(4)));
typedef unsigned v2u __attribute__((ext_vector_type(2)));
typedef float f32x4 __attribute__((ext_vector_type(4)));
typedef float f32x2 __attribute__((ext_vector_type(2)));
typedef float f32x16 __attribute__((ext_vector_type(16)));
typedef short bf16x8 __attribute__((ext_vector_type(8)));
typedef short s16x4 __attribute__((ext_vector_type(4)));
typedef GAS unsigned gu32;
#define RLX_AGENT __ATOMIC_RELAXED, __HIP_MEMORY_SCOPE_AGENT
#define LDS_WAIT() asm volatile("s_waitcnt lgkmcnt(0)" ::: "memory")
#define VM_WAIT() asm volatile("s_waitcnt vmcnt(0)" ::: "memory")

__device__ __forceinline__ unsigned f2bf(float f) { unsigned u = __builtin_bit_cast(unsigned, f); return (u + 0x7fffu + ((u >> 16) & 1u)) >> 16; }
__device__ __forceinline__ unsigned pk2(float lo, float hi) { return f2bf(lo) | (f2bf(hi) << 16); }
__device__ __forceinline__ float bf2f(unsigned short b) { return __builtin_bit_cast(float, (unsigned)b << 16); }
__device__ __forceinline__ unsigned cvt_pk_bf16(float lo, float hi) { unsigned r; asm volatile("v_cvt_pk_bf16_f32 %0, %1, %2" : "=v"(r) : "v"(lo), "v"(hi)); return r; }
__device__ __forceinline__ unsigned pk4_fp8(float a, float b, float c, float d) { unsigned w = 0u; w = (unsigned)__builtin_amdgcn_cvt_pk_fp8_f32(a, b, (int)w, false); w = (unsigned)__builtin_amdgcn_cvt_pk_fp8_f32(c, d, (int)w, true); return w; }
__device__ __forceinline__ float wave_sum(float v) {
#pragma unroll
    for (int o = 1; o < 64; o <<= 1) v += __shfl_xor(v, o);
    return v;
}

namespace pg8 {
#define PG8_LAS __attribute__((address_space(3)))
typedef unsigned short bf16_t;
typedef int v4i_t __attribute__((ext_vector_type(4)));
typedef int v8i_t __attribute__((ext_vector_type(8)));
constexpr int LCAP = 16384;
constexpr int BM = 256, BK = 64, HALF = 128, HTB = HALF * BK * 2, STAGE_BYTES = 8 * HTB, NXCD = 8, WGM = 8;
__host__ __device__ __forceinline__ int lds_byte(int r, int c) { const int st = (r >> 4) * 2 + (c >> 5), rr = r & 15, cc = c & 31, ob = rr * 64 + cc * 2; return st * 1024 + (ob ^ (((ob >> 9) & 1) << 5)); }
__host__ __device__ __forceinline__ void stage_rc(int b, int& R, int& C) { const int st = b / 1024, sb = b % 1024, swz = sb ^ (((sb >> 9) & 1) << 5); R = (st >> 1) * 16 + swz / 64; C = (st & 1) * 32 + (swz % 64) / 2; }
__host__ __device__ __forceinline__ int perm32(int rho) { const int n = rho >> 4, i = rho & 15; return 8 * (i >> 2) + 4 * n + (i & 3); }

struct Unit { int pm, pn, e, rl0, cnt; };
struct Gemm { const void* A; const void* Bt; int Kb; size_t bstride; const int* lst; };

struct StaticOrder {
    int nM, nN, nwg, G, c;
    int reps;
    __device__ void init(int M, int N, int G_, int c_, int reps_ = 1) { nM = M / BM; nN = N / BM; nwg = nM * nN; G = G_; c = c_; reps = reps_; }
    __device__ bool next(int i, Unit& u) const {
        const long L0 = (long)i * G + c; if (L0 >= (long)nwg * reps) return false;
        const long L = L0 % nwg;
        int wgid = (int)L; { const int q = nwg / NXCD, r = nwg % NXCD, xcd = wgid % NXCD, off = wgid / NXCD; wgid = (xcd < r ? xcd * (q + 1) : r * (q + 1) + (xcd - r) * q) + off; }
        const int nig = WGM * nN, gid = wgid / nig, fm = gid * WGM, gsz = (nM - fm) < WGM ? (nM - fm) : WGM;
        u.pm = fm + ((wgid % nig) % gsz); u.pn = (wgid % nig) / gsz; u.e = 0; u.rl0 = 0; u.cnt = 0; return true;
    }
};
struct GroupOrder {
    int ntiles, nN, G, c; const PG8_LAS int* tab;
    int L0, Lend;
    __device__ bool next(int i, Unit& u) const {
        const int L = L0 + i * G + c; if (L < 0 || L >= Lend) return false;
        const int t = L / nN; u.pm = t; u.pn = L - t * nN; u.e = __builtin_amdgcn_readfirstlane(tab[128 + t]);
        u.rl0 = t * BM - __builtin_amdgcn_readfirstlane(tab[u.e]); u.cnt = __builtin_amdgcn_readfirstlane(tab[96 + u.e]); return true;
    }
};

template <class Epi, class Sched, bool GATHER = false, bool F8 = false, int SA = 127, int SB = 127>
__device__ __forceinline__ void gemm_phase(PG8_LAS unsigned char* lds, const Gemm g, const Sched& S, const Epi& E) {
    const int tid = threadIdx.x, wid = __builtin_amdgcn_readfirstlane(tid >> 6), lane = tid & 63, wr = wid >> 2, wc = wid & 3, fr = lane & 15, fq = lane >> 4;
    const int Kb = g.Kb, nt = Kb / 128;
    unsigned voffA[2], voffB[2];
#pragma unroll
    for (int i = 0; i < 2; ++i) { int R, C; stage_rc(tid * 16 + i * 8192, R, C); const int Rb = Epi::PERM ? ((R & ~31) + perm32(R & 31)) : R;
        voffA[i] = (unsigned)(R * Kb + C * 2); voffB[i] = (unsigned)(Rb * Kb + C * 2); }
    unsigned vC[2][2], vN[2][2];
#define PG8_GOFF(dst, u_) do { _Pragma("unroll") for (int _h = 0; _h < 2; ++_h) _Pragma("unroll") for (int _i = 0; _i < 2; ++_i) { int R_, C_; stage_rc(tid * 16 + _i * 8192, R_, C_); \
        const int rl_ = (u_).rl0 + _h * HALF + R_; const int tk_ = rl_ < (u_).cnt ? g.lst[(u_).e * LCAP + rl_] : 0; dst[_h][_i] = (unsigned)(tk_ * Kb + C_ * 2); } } while (0)
    const size_t kstep = (size_t)(BK * 2);
    const size_t hstep = (size_t)HALF * Kb;
    const size_t tstep = 2 * hstep;
    const unsigned ldsw = (unsigned)wid * 1024u;
    const int aoff = lds_byte(wr * 64 + fr, fq * 8), boff = lds_byte(wc * 32 + fr, fq * 8);
#define PG8_SA(b, h) (((b) * 2 + (h)) * HTB)
#define PG8_SB(b, h) ((4 + (b) * 2 + (h)) * HTB)
#define PG8_STAGE(bufoff, gbase, voff) do { _Pragma("unroll") for (int _i = 0; _i < 2; ++_i) \
        __builtin_amdgcn_global_load_lds((const unsigned*)((const char*)(gbase) + (voff)[_i]), (PG8_LAS unsigned*)(lds + (bufoff) + ldsw + _i * 8192), 16, 0, 0); } while (0)
#define PG8_STAGE_A(bufoff, gbase, hh, nx) do { if constexpr (GATHER) { _Pragma("unroll") for (int _i = 0; _i < 2; ++_i) { const unsigned _v = (nx) ? vN[hh][_i] : vC[hh][_i]; \
        __builtin_amdgcn_global_load_lds((const unsigned*)((const char*)(gbase) + _v), (PG8_LAS unsigned*)(lds + (bufoff) + ldsw + _i * 8192), 16, 0, 0); } } \
        else { PG8_STAGE(bufoff, (gbase) + (hh) * hstep, voffA); } } while (0)
#define PG8_LDA(dst, b, h) do { if constexpr (F8) { _Pragma("unroll") for (int m = 0; m < 4; ++m) { const v4i_t lo_ = *(const PG8_LAS v4i_t*)(lds + PG8_SA(b, h) + aoff + m * 2048), hi_ = *(const PG8_LAS v4i_t*)(lds + PG8_SA(b, h) + aoff + m * 2048 + 1024); \
            dst##8[m] = __builtin_shufflevector(lo_, hi_, 0, 1, 2, 3, 4, 5, 6, 7); } } \
        else { _Pragma("unroll") for (int m = 0; m < 4; ++m) _Pragma("unroll") for (int k = 0; k < 2; ++k) dst[m][k] = *(const PG8_LAS bf16x8*)(lds + PG8_SA(b, h) + aoff + m * 2048 + k * 1024); } } while (0)
#define PG8_LDB(dst, b, h) do { if constexpr (F8) { _Pragma("unroll") for (int n = 0; n < 2; ++n) { const v4i_t lo_ = *(const PG8_LAS v4i_t*)(lds + PG8_SB(b, h) + boff + n * 2048), hi_ = *(const PG8_LAS v4i_t*)(lds + PG8_SB(b, h) + boff + n * 2048 + 1024); \
            dst##8[n] = __builtin_shufflevector(lo_, hi_, 0, 1, 2, 3, 4, 5, 6, 7); } } \
        else { _Pragma("unroll") for (int n = 0; n < 2; ++n) _Pragma("unroll") for (int k = 0; k < 2; ++k) dst[n][k] = *(const PG8_LAS bf16x8*)(lds + PG8_SB(b, h) + boff + n * 2048 + k * 1024); } } while (0)
#define PG8_MMA(ai, bj, At, Bt) do { __builtin_amdgcn_s_setprio(1); \
        if constexpr (F8) { _Pragma("unroll") for (int m = 0; m < 4; ++m) _Pragma("unroll") for (int n = 0; n < 2; ++n) \
            asm volatile("v_mfma_scale_f32_16x16x128_f8f6f4 %0, %1, %2, %0, %3, %4 op_sel_hi:[0,0,0]" : "+v"(acc[ai][bj][m][n]) : "v"(Bt##8[n]), "v"(At##8[m]), "v"(sca), "v"(scb)); } \
        else { _Pragma("unroll") for (int m = 0; m < 4; ++m) _Pragma("unroll") for (int n = 0; n < 2; ++n) _Pragma("unroll") for (int k = 0; k < 2; ++k) \
            acc[ai][bj][m][n] = __builtin_amdgcn_mfma_f32_16x16x32_bf16(Bt[n][k], At[m][k], acc[ai][bj][m][n], 0, 0, 0); } \
        __builtin_amdgcn_s_setprio(0); } while (0)
#define PG8_WAIT_V(n) asm volatile("s_waitcnt vmcnt(" #n ")" ::: "memory")
#define PG8_WAIT_L(n) asm volatile("s_waitcnt lgkmcnt(" #n ")" ::: "memory")
#define PG8_BAR __builtin_amdgcn_s_barrier()
#define PG8_SCHED __builtin_amdgcn_sched_barrier(0)
    Unit cur, nxt; int ui = 0;
    if (!S.next(0, cur)) return;
    f32x4 acc[2][2][4][2];
#pragma unroll
    for (int a = 0; a < 2; ++a)
#pragma unroll
        for (int b = 0; b < 2; ++b)
#pragma unroll
            for (int m = 0; m < 4; ++m)
#pragma unroll
                for (int n = 0; n < 2; ++n) acc[a][b][m][n] = (f32x4){0.f, 0.f, 0.f, 0.f};
    const int sca = SA, scb = SB;
    bf16x8 At[4][2], B0[2][2], B1[2][2]; v8i_t At8[4], B08[2], B18[2];
    const char* cA = GATHER ? (const char*)g.A : (const char*)g.A + (size_t)cur.pm * tstep; const char* cB = (const char*)g.Bt + (size_t)cur.e * g.bstride + (size_t)cur.pn * tstep;
    if constexpr (GATHER) { PG8_GOFF(vC, cur); }
    PG8_STAGE(PG8_SB(0, 0), cB, voffB); PG8_STAGE(PG8_SB(0, 1), cB + hstep, voffB); PG8_STAGE_A(PG8_SA(0, 0), cA, 0, false); PG8_STAGE_A(PG8_SA(0, 1), cA, 1, false);
    if (wr == 1) PG8_BAR;
    PG8_WAIT_V(2); PG8_BAR;
    PG8_STAGE(PG8_SB(1, 0), cB + kstep, voffB); PG8_STAGE_A(PG8_SA(1, 0), cA + kstep, 0, false); PG8_STAGE(PG8_SB(1, 1), cB + hstep + kstep, voffB);
    PG8_WAIT_V(6); PG8_BAR;
    for (;;) {
        const bool has_next = S.next(ui + 1, nxt);
        const char* nA = GATHER ? cA : (has_next ? (const char*)g.A + (size_t)nxt.pm * tstep : cA);
        if constexpr (GATHER) { if (has_next) { PG8_GOFF(vN, nxt); } else {
#pragma unroll
            for (int _h = 0; _h < 2; ++_h)
#pragma unroll
                for (int _i = 0; _i < 2; ++_i) vN[_h][_i] = vC[_h][_i]; } }
        const char* nB = has_next ? (const char*)g.Bt + (size_t)nxt.e * g.bstride + (size_t)nxt.pn * tstep : cB;
#pragma unroll 1
        for (int t = 0; t < nt; t += 2) {
            const bool last = (t == nt - 2);
            const char* a1 = cA + (size_t)(t + 1) * kstep;
            const char* a2 = last ? nA : cA + (size_t)(t + 2) * kstep; const char* b2 = last ? nB : cB + (size_t)(t + 2) * kstep;
            const char* a3 = a2 + kstep; const char* b3 = b2 + kstep;
            PG8_LDB(B0, 0, 0); PG8_LDB(B1, 0, 1); PG8_SCHED; PG8_LDA(At, 0, 0); PG8_STAGE_A(PG8_SA(1, 1), a1, 1, false);
            PG8_WAIT_V(8); PG8_WAIT_L(0); PG8_BAR; PG8_MMA(0, 0, At, B0); PG8_MMA(0, 1, At, B1); PG8_BAR; PG8_SCHED;
            PG8_LDA(At, 0, 1); PG8_STAGE(PG8_SB(0, 0), b2, voffB); PG8_STAGE(PG8_SB(0, 1), b2 + hstep, voffB); PG8_STAGE_A(PG8_SA(0, 0), a2, 0, last);
            PG8_WAIT_V(8); PG8_WAIT_L(0); PG8_BAR; PG8_MMA(1, 0, At, B0); PG8_MMA(1, 1, At, B1); PG8_BAR; PG8_SCHED;
            PG8_LDB(B0, 1, 0); PG8_LDB(B1, 1, 1); PG8_SCHED; PG8_LDA(At, 1, 0); PG8_STAGE_A(PG8_SA(0, 1), a2, 1, last);
            PG8_WAIT_V(8); PG8_WAIT_L(0); PG8_BAR; PG8_MMA(0, 0, At, B0); PG8_MMA(0, 1, At, B1); PG8_BAR; PG8_SCHED;
            PG8_LDA(At, 1, 1); PG8_STAGE(PG8_SB(1, 0), b3, voffB); PG8_STAGE(PG8_SB(1, 1), b3 + hstep, voffB); PG8_STAGE_A(PG8_SA(1, 0), a3, 0, last);
            PG8_WAIT_V(8); PG8_WAIT_L(0); PG8_BAR; PG8_MMA(1, 0, At, B0); PG8_MMA(1, 1, At, B1); PG8_BAR; PG8_SCHED;
        }
        if (wr == 0) PG8_BAR;
        if constexpr (F8) asm volatile("s_nop 15\n\ts_nop 15" ::: "memory");
        E(acc, cur, wr, wc, fr, fq);
        if (!has_next) break;
#pragma unroll
        for (int a = 0; a < 2; ++a)
#pragma unroll
            for (int b = 0; b < 2; ++b)
#pragma unroll
                for (int m = 0; m < 4; ++m)
#pragma unroll
                    for (int n = 0; n < 2; ++n) acc[a][b][m][n] = (f32x4){0.f, 0.f, 0.f, 0.f};
        cur = nxt; cA = nA; cB = nB; ++ui;
        if constexpr (GATHER) {
#pragma unroll
            for (int _h = 0; _h < 2; ++_h)
#pragma unroll
                for (int _i = 0; _i < 2; ++_i) vC[_h][_i] = vN[_h][_i]; }
        if (wr == 1) PG8_BAR;
    }
    PG8_WAIT_V(0);
    PG8_BAR;
#undef PG8_SA
#undef PG8_SB
#undef PG8_STAGE
#undef PG8_STAGE_A
#undef PG8_GOFF
#undef PG8_LDA
#undef PG8_LDB
#undef PG8_MMA
#undef PG8_WAIT_V
#undef PG8_WAIT_L
#undef PG8_BAR
#undef PG8_SCHED
}

struct EpiProj {
    static constexpr bool PERM = true;
    bf16_t* O; const f32x2* rope;
    __device__ __forceinline__ void operator()(const f32x4 (&acc)[2][2][4][2], const Unit& u, int wr, int wc, int fr, int fq) const {
        const int row0 = u.pm * BM + wr * 64 + fr, col0 = u.pn * BM + wc * 32 + 8 * fq;
        const int mode = (u.pn < 4) ? 1 : ((u.pn >= 12 && u.pn < 16) ? 2 : 0);
        const float sc = (mode == 1) ? QSCALE : ((u.pn >= 14 && u.pn < 16) ? 0.125f : 1.0f);
#pragma unroll
        for (int ai = 0; ai < 2; ++ai)
#pragma unroll
            for (int m = 0; m < 4; ++m) { const int row = row0 + ai * HALF + m * 16; bf16_t* rowp = O + (size_t)row * NPROJ + col0;
#pragma unroll
                for (int bj = 0; bj < 2; ++bj) { f32x4 v0 = acc[ai][bj][m][0], v1 = acc[ai][bj][m][1];
                    if (mode == 2) { const int t0 = ((col0 + bj * HALF) & 63) >> 1; const f32x4* rp = (const f32x4*)(rope + (size_t)(row & (SEQ - 1)) * 32 + t0);
                        const f32x4 c0 = rp[0], c1 = rp[1];
                        f32x4 w0, w1;
                        w0[0] = v0[0] * c0[0] - v0[1] * c0[1]; w0[1] = v0[0] * c0[1] + v0[1] * c0[0];
                        w0[2] = v0[2] * c0[2] - v0[3] * c0[3]; w0[3] = v0[2] * c0[3] + v0[3] * c0[2];
                        w1[0] = v1[0] * c1[0] - v1[1] * c1[1]; w1[1] = v1[0] * c1[1] + v1[1] * c1[0];
                        w1[2] = v1[2] * c1[2] - v1[3] * c1[3]; w1[3] = v1[2] * c1[3] + v1[3] * c1[2];
                        v0 = w0; v1 = w1; }
                    v0 = v0 * sc; v1 = v1 * sc; v4u w; w.x = cvt_pk_bf16(v0[0], v0[1]); w.y = cvt_pk_bf16(v0[2], v0[3]); w.z = cvt_pk_bf16(v1[0], v1[1]); w.w = cvt_pk_bf16(v1[2], v1[3]);
                    *(v4u*)(rowp + bj * HALF) = w; } }
    }
};
struct EpiRes {
    static constexpr bool PERM = true;
    const bf16_t* xn; const float* irs1; const float* g1; bf16_t* X1; unsigned char* XG; const float* g2;
    __device__ __forceinline__ void operator()(const f32x4 (&acc)[2][2][4][2], const Unit& u, int wr, int wc, int fr, int fq) const {
        const int row0 = u.pm * BM + wr * 64 + fr, col0 = u.pn * BM + wc * 32 + 8 * fq;
        f32x4 ig[2][2];
#pragma unroll
        for (int bj = 0; bj < 2; ++bj)
#pragma unroll
            for (int n = 0; n < 2; ++n) { const f32x4 t = *(const f32x4*)(g1 + col0 + bj * HALF + 4 * n); ig[bj][n] = (f32x4){1.0f / t[0], 1.0f / t[1], 1.0f / t[2], 1.0f / t[3]}; }
#pragma unroll
        for (int ai = 0; ai < 2; ++ai) {
            v4u xb[4][2]; float ir[4];
#pragma unroll
            for (int m = 0; m < 4; ++m) { ir[m] = irs1[row0 + ai * HALF + m * 16];
#pragma unroll
                for (int bj = 0; bj < 2; ++bj) xb[m][bj] = *(const v4u*)(xn + (size_t)(row0 + ai * HALF + m * 16) * DM + col0 + bj * HALF); }
#pragma unroll
            for (int m = 0; m < 4; ++m) { const size_t off = (size_t)(row0 + ai * HALF + m * 16) * DM + col0;
#pragma unroll
                for (int bj = 0; bj < 2; ++bj) { const v4u xw = xb[m][bj]; const float rr = ir[m];
                    const f32x4 x0 = (f32x4){bf2f(xw.x & 0xffff), bf2f(xw.x >> 16), bf2f(xw.y & 0xffff), bf2f(xw.y >> 16)} * ig[bj][0] * rr, x1 = (f32x4){bf2f(xw.z & 0xffff), bf2f(xw.z >> 16), bf2f(xw.w & 0xffff), bf2f(xw.w >> 16)} * ig[bj][1] * rr;
                    const f32x4 v0 = x0 + acc[ai][bj][m][0], v1 = x1 + acc[ai][bj][m][1];
                    v4u w; w.x = cvt_pk_bf16(v0[0], v0[1]); w.y = cvt_pk_bf16(v0[2], v0[3]); w.z = cvt_pk_bf16(v1[0], v1[1]); w.w = cvt_pk_bf16(v1[2], v1[3]);
                    *(v4u*)(X1 + off + bj * HALF) = w;
                } } }
    }
};
struct EpiSwiglu {
    static constexpr bool PERM = true;
    unsigned char* O; const float* lst_rs;
    __device__ __forceinline__ void operator()(const f32x4 (&acc)[2][2][4][2], const Unit& u, int wr, int wc, int fr, int fq) const {
        const int row0 = u.pm * BM + wr * 64 + fr, f0 = u.pn * 128 + wc * 16 + 4 * fq;
#pragma unroll
        for (int ai = 0; ai < 2; ++ai)
#pragma unroll
            for (int m = 0; m < 4; ++m) { const int row = row0 + ai * HALF + m * 16; const float rs = lst_rs[u.e * LCAP + u.rl0 + (row - u.pm * BM)]; unsigned char* rowp = O + (size_t)row * FF + f0;
#pragma unroll
                for (int bj = 0; bj < 2; ++bj) { const f32x4 a = acc[ai][bj][m][0] * rs, b = acc[ai][bj][m][1] * rs; f32x4 r;
#pragma unroll
                    for (int j = 0; j < 4; ++j) r[j] = a[j] * __builtin_amdgcn_rcpf(1.0f + __builtin_amdgcn_exp2f(-a[j] * LOG2E)) * b[j];
                    *(unsigned*)(rowp + bj * 64) = pk4_fp8(r[0], r[1], r[2], r[3]); } }
    }
};
struct EpiDown {
    static constexpr bool PERM = true;
    unsigned char* O; const float* lst_gate;
    __device__ __forceinline__ void operator()(const f32x4 (&acc)[2][2][4][2], const Unit& u, int wr, int wc, int fr, int fq) const {
        const int row0 = u.pm * BM + wr * 64 + fr, col0 = u.pn * BM + wc * 32 + 8 * fq;
#pragma unroll
        for (int ai = 0; ai < 2; ++ai)
#pragma unroll
            for (int m = 0; m < 4; ++m) { const int row = row0 + ai * HALF + m * 16; const float gt = lst_gate[u.e * LCAP + u.rl0 + (row - u.pm * BM)] * YSCALE; unsigned char* rowp = O + (size_t)row * DM + col0;
#pragma unroll
                for (int bj = 0; bj < 2; ++bj) { const f32x4 v0 = acc[ai][bj][m][0] * gt, v1 = acc[ai][bj][m][1] * gt;
                    v2u w; w.x = pk4_fp8(v0[0], v0[1], v0[2], v0[3]); w.y = pk4_fp8(v1[0], v1[1], v1[2], v1[3]);
                    *(v2u*)(rowp + bj * HALF) = w; } }
    }
};
}

namespace att {
constexpr int KOFF0 = 0, KOFF1 = 8192, VOFF = 16384, BUFB = 32768;
constexpr int TBOFF = 65536, WSFOFF = 66816, QFOFF0 = 69632, QFOFF1 = 98304;
constexpr int STG_PITCH = 132, STG_WAVE = 32 * STG_PITCH * 4;
constexpr float THR = 8.0f;
__device__ __forceinline__ int crow(int r, int hi) { return (r & 3) + 8 * (r >> 2) + 4 * hi; }
__device__ __forceinline__ s16x4 vtr(const LAS unsigned char* p) { typedef short v4i16_t __attribute__((ext_vector_type(4))); return __builtin_bit_cast(s16x4, __builtin_amdgcn_ds_read_tr16_b64_v4i16((LAS v4i16_t*)p)); }

struct Args { const bf16* proj; bf16* mix; const float* tb; const float* subln_g; const float* gn_g; float lam; };

#define ATT_SRC(L) unsigned ksrc, vsrc; \
    { const int row_ = 8 * wid + ((L) >> 3), slot_ = (L) & 7, ch_ = slot_ ^ ((row_ >> 1) & 7); ksrc = (unsigned)(row_ * NPROJ + ck + ch_ * 8) * 2u; } \
    { const int row_ = 8 * wid + ((L) >> 4), slot_ = (L) & 15; vsrc = (unsigned)(row_ * NPROJ + cv + ((slot_ ^ ((row_ & 3) << 2)) * 8)) * 2u; }
#define ATT_STAGE(t, bufo) do { const char* _b = pbase + (size_t)(t) * 64 * NPROJ * 2; \
        __builtin_amdgcn_global_load_lds((const unsigned*)(_b + ksrc), (LAS unsigned*)(lds + (bufo) + KOFF0 + ldsw), 16, 0, 0); \
        if (MODE == 0) __builtin_amdgcn_global_load_lds((const unsigned*)(_b + ksrc + 128), (LAS unsigned*)(lds + (bufo) + KOFF1 + ldsw), 16, 0, 0); \
        __builtin_amdgcn_global_load_lds((const unsigned*)(_b + vsrc), (LAS unsigned*)(lds + (bufo) + VOFF + 2 * ldsw), 16, 0, 0); \
        __builtin_amdgcn_global_load_lds((const unsigned*)(_b + vsrc + 4 * NPROJ * 2), (LAS unsigned*)(lds + (bufo) + VOFF + 2 * ldsw + 1024), 16, 0, 0); } while (0)

constexpr float WSCALE = 32.0f;
struct Bg { const float* wg; const float* wu; const float* wd; unsigned char* btgu; unsigned char* btd; int it, end; bool have; f32x4 r[8]; };
__device__ __forceinline__ void bg_decode(const Bg& B, int it, int lane, const float*& src, int& N, unsigned char*& dst, int& K) {
    const int me = it >> 10, r = it & 1023, e = me / 3, w = me - 3 * e, n4 = lane & 7, kr = lane >> 3;
    if (w == 2) { N = DM; K = FF; const int kb = r >> 6, nb = r & 63, nn = 32 * nb + 4 * n4, k0 = 64 * kb + 8 * kr; src = B.wd + (size_t)e * FF * DM + (size_t)k0 * DM + nn; dst = B.btd + (size_t)e * DM * FF + (size_t)nn * FF + k0; }
    else { N = FF; K = DM; const int kb = r >> 5, nb = r & 31, nn = 32 * nb + 4 * n4, k0 = 64 * kb + 8 * kr; src = (w == 0 ? B.wg : B.wu) + (size_t)e * DM * FF + (size_t)k0 * FF + nn;
           dst = B.btgu + (size_t)e * 2048 * DM + (size_t)(8 * (nn >> 2) + 4 * w) * DM + k0; }
}
__device__ __forceinline__ void bg_issue(Bg& B, int lane) {
    if (BG_MODE != 0 && B.it < B.end) { const float* src; unsigned char* dst; int N, K; bg_decode(B, B.it, lane, src, N, dst, K);
#pragma unroll
        for (int j = 0; j < 8; ++j) B.r[j] = __builtin_nontemporal_load((const f32x4*)(src + (size_t)j * N));
        B.have = true; ++B.it; }
}
__device__ __forceinline__ void bg_retire(Bg& B, int lane) {
    if (B.have) { const float* src; unsigned char* dst; int N, K; bg_decode(B, B.it - 1, lane, src, N, dst, K);
#pragma unroll
        for (int i = 0; i < 4; ++i) { v2u w; w.x = pk4_fp8(B.r[0][i] * WSCALE, B.r[1][i] * WSCALE, B.r[2][i] * WSCALE, B.r[3][i] * WSCALE); w.y = pk4_fp8(B.r[4][i] * WSCALE, B.r[5][i] * WSCALE, B.r[6][i] * WSCALE, B.r[7][i] * WSCALE);
            *(v2u*)(dst + (size_t)i * K) = w; }
        B.have = false; }
}

template <int MODE>
__device__ __forceinline__ void attn_unit(const Args& A, Bg& BG, int b, int h, int qb, LAS unsigned char* lds) {
    constexpr int NMAP = (MODE == 0) ? 2 : 1, NBUF = (MODE == 0) ? 2 : 3, QFOFF = (MODE == 0) ? QFOFF0 : QFOFF1, NGL = (MODE == 0) ? 4 : 3;
    int tid = threadIdx.x; asm volatile("" : "+v"(tid));
    const int lane = tid & 63, wid = __builtin_amdgcn_readfirstlane(tid >> 6);
    const int q0 = qb * 256, qw = q0 + wid * 32;
    const size_t rowbase = (size_t)b * SEQ;
    const int cq = (MODE == 0) ? C_DQ + h * 128 : C_RQ + h * 64;
    const int ck = (MODE == 0) ? C_DK + h * 128 : C_RK + h * 64;
    const int cv = (MODE == 0) ? C_DV + h * 128 : C_RV + h * 128;
    const int NT = (q0 + 256) / 64;
    const int ntw = (qw + 31) / 64 + 1;
    const char* pbase = (const char*)(A.proj + rowbase * NPROJ);
    const unsigned ldsw = (unsigned)wid * 1024u;
    LAS float* tbl = (LAS float*)(lds + TBOFF);
    { ATT_SRC(lane); ATT_STAGE(0, 0); if (NBUF == 3 && NT > 1) ATT_STAGE(1, BUFB); }
    if (MODE == 0) { if (tid < 304) tbl[tid] = A.tb[h * 304 + tid]; }
    { LAS unsigned char* qw_ = lds + QFOFF + wid * (NMAP * 4096) + lane * 16; const char* qg = pbase + (size_t)((qw + (lane & 31)) * NPROJ + cq + (lane >> 5) * 8) * 2;
#pragma unroll
      for (int f = 0; f < NMAP * 4; ++f) *(LAS v4u*)(qw_ + f * 1024) = *(const v4u*)(qg + (f >> 2) * 128 + (f & 3) * 32); }
    f32x16 o[NMAP][4];
#pragma unroll
    for (int c = 0; c < NMAP; ++c)
#pragma unroll
        for (int d = 0; d < 4; ++d)
#pragma unroll
            for (int r = 0; r < 16; ++r) o[c][d][r] = 0.f;
    float mref[NMAP], lsum[NMAP];
#pragma unroll
    for (int c = 0; c < NMAP; ++c) { mref[c] = -INFINITY; lsum[c] = 0.f; }
    float cg = 0.f;
    if (MODE == 1) { const double x = __builtin_ldexp(1.0, -5 - h); const double s = x * (1.0 + x * (0.5 + x * (1.0 / 3 + x * (0.25 + x * (0.2 + x * (1.0 / 6 + x * (1.0 / 7)))))));
        cg = (float)(-s * 1.4426950408889634); }
    VM_WAIT(); __syncthreads();
    for (int t = 0; t < NT; ++t) {
        const int bufo = (NBUF == 2 ? (t & 1) : (t % 3)) * BUFB, t0 = t * 64;
        int ln = lane; asm volatile("" : "+v"(ln));
        const bool staged = (t + NBUF - 1 < NT);
        if (staged) { ATT_SRC(ln); ATT_STAGE(t + NBUF - 1, ((t + NBUF - 1) % NBUF) * BUFB); }
        bool bg_now = false;
#define ATT_BGMID() do { bg_retire(BG, ln); const int ib_ = BG.it; if (MODE == 0 || (t % 3) == 0) bg_issue(BG, ln); bg_now = BG.it != ib_; } while (0)
        if (t >= ntw) ATT_BGMID();
        if (t < ntw) {
            const int r32 = ln & 31, hi = ln >> 5;
            const LAS unsigned char* kb = lds + bufo; const LAS unsigned char* vb = lds + bufo + VOFF;
            const bool near = (qw - t0) <= 175, diag = (t0 + 63) > qw;
            const int kbase = r32 * 128 + ((((r32 >> 2) & 3)) << 5) + ((hi ^ ((r32 >> 1) & 1)) << 4);
            int vbase;
            { const int i16 = ln & 15, q = i16 >> 2, p = i16 & 3, g = (ln >> 4) & 1; vbase = (4 * hi + q) * 256 + (((q << 2) + 2 * g + (p >> 1)) << 4) + 8 * (p & 1); }
            const LAS unsigned char* qlds = lds + QFOFF + wid * (NMAP * 4096) + ln * 16;
            LAS float* wsf = (LAS float*)(lds + WSFOFF) + wid * 64;
#pragma unroll
            for (int kh = 0; kh < 2; ++kh) {
              if (kh == 1) ATT_BGMID();
              if (t0 + 32 * kh > qw + 31) continue;
#pragma unroll
              for (int c = 0; c < NMAP; ++c) {
                f32x16 p;
                __builtin_amdgcn_sched_barrier(0);
                if (MODE == 0 && near) { const LAS float* tp = tbl + (207 - (qw + r32 - t0) + 4 * hi + 32 * kh);
#pragma unroll
                    for (int r = 0; r < 16; ++r) p[r] = tp[(r & 3) + 8 * (r >> 2)];
                } else { const float ini = (MODE == 0) ? tbl[0] : 0.f;
#pragma unroll
                    for (int r = 0; r < 16; ++r) p[r] = ini; }
#pragma unroll
                for (int s = 0; s < 4; ++s) {
                    const bf16x8 qf = *(const LAS bf16x8*)(qlds + (c * 4 + s) * 1024);
                    const bf16x8 kf = *(const LAS bf16x8*)(kb + c * KOFF1 + (kbase ^ (s << 5)) + kh * 4096);
                    p = __builtin_amdgcn_mfma_f32_32x32x16_bf16(kf, qf, p, 0, 0, 0);
                }
                const int qrel = qw + r32 - t0 - 4 * hi - 32 * kh;
                if (MODE == 0) {
                    if (diag) {
#pragma unroll
                        for (int r = 0; r < 16; ++r) { if ((r & 3) + 8 * (r >> 2) > qrel) p[r] = -INFINITY; } }
                    float rm = fmaxf(p[0], p[1]);
#pragma unroll
                    for (int r = 2; r < 16; ++r) rm = fmaxf(rm, p[r]);
                    { auto rr = __builtin_amdgcn_permlane32_swap(__float_as_uint(rm), __float_as_uint(rm), false, false); rm = fmaxf(__uint_as_float(rr[0]), __uint_as_float(rr[1])); }
                    if (__any(rm > mref[c] + THR)) {
                        const float mn = fmaxf(mref[c], rm); const float al = __builtin_amdgcn_exp2f(mref[c] - mn);
                        lsum[c] *= al; mref[c] = mn;
                        if (hi == 0) wsf[r32] = al;
                        LDS_WAIT();
#pragma unroll
                        for (int r = 0; r < 16; ++r) { const float a = wsf[crow(r, hi)];
#pragma unroll
                            for (int d = 0; d < 4; ++d) o[c][d][r] *= a; }
                        LDS_WAIT();
                    }
                    const float mm = mref[c]; float sacc = 0.f;
#pragma unroll
                    for (int r = 0; r < 16; ++r) { p[r] = __builtin_amdgcn_exp2f(p[r] - mm); sacc += p[r]; }
                    lsum[c] += sacc;
                } else {
                    const float rf = __builtin_amdgcn_exp2f(cg * (float)(qw + r32 - t0 - 32 * kh));
#pragma unroll
                    for (int r = 0; r < 16; ++r) { const float cf = __builtin_amdgcn_exp2f(-cg * (float)crow(r, hi)); p[r] = p[r] * (cf * rf); }
                    if (diag) {
#pragma unroll
                        for (int r = 0; r < 16; ++r) { if ((r & 3) + 8 * (r >> 2) > qrel) p[r] = 0.f; } }
                }
                v4u pa[2];
                pa[0] = (v4u){cvt_pk_bf16(p[0], p[1]), cvt_pk_bf16(p[2], p[3]), cvt_pk_bf16(p[4], p[5]), cvt_pk_bf16(p[6], p[7])};
                pa[1] = (v4u){cvt_pk_bf16(p[8], p[9]), cvt_pk_bf16(p[10], p[11]), cvt_pk_bf16(p[12], p[13]), cvt_pk_bf16(p[14], p[15])};
                { s16x4 va[4], vbq[4];
                  const int vad0 = (int)(uintptr_t)vb + (vbase ^ (0 << 6)) + kh * 8192, vad1 = (int)(uintptr_t)vb + (vbase ^ (1 << 6)) + kh * 8192;
                  const int vad2 = (int)(uintptr_t)vb + (vbase ^ (2 << 6)) + kh * 8192, vad3 = (int)(uintptr_t)vb + (vbase ^ (3 << 6)) + kh * 8192;
#define ATT_VRD(dst, ad) do { asm volatile("ds_read_b64_tr_b16 %0, %1" : "=v"(dst[0]) : "v"(ad) : "memory"); asm volatile("ds_read_b64_tr_b16 %0, %1 offset:2048" : "=v"(dst[1]) : "v"(ad) : "memory"); \
                                   asm volatile("ds_read_b64_tr_b16 %0, %1 offset:4096" : "=v"(dst[2]) : "v"(ad) : "memory"); asm volatile("ds_read_b64_tr_b16 %0, %1 offset:6144" : "=v"(dst[3]) : "v"(ad) : "memory"); } while (0)
#define ATT_VWAIT() do { asm volatile("s_waitcnt lgkmcnt(0)" ::: "memory"); __builtin_amdgcn_sched_barrier(0); } while (0)
#define ATT_PV(d, vv) do { o[c][d] = __builtin_amdgcn_mfma_f32_32x32x16_bf16(__builtin_bit_cast(bf16x8, pa[0]), ((bf16x8){vv[0][0], vv[0][1], vv[0][2], vv[0][3], vv[1][0], vv[1][1], vv[1][2], vv[1][3]}), o[c][d], 0, 0, 0); \
                                o[c][d] = __builtin_amdgcn_mfma_f32_32x32x16_bf16(__builtin_bit_cast(bf16x8, pa[1]), ((bf16x8){vv[2][0], vv[2][1], vv[2][2], vv[2][3], vv[3][0], vv[3][1], vv[3][2], vv[3][3]}), o[c][d], 0, 0, 0); } while (0)
                  __builtin_amdgcn_sched_barrier(0);
                  ATT_VRD(va, vad0); ATT_VWAIT();
                  ATT_VRD(vbq, vad1); __builtin_amdgcn_sched_barrier(0); ATT_PV(0, va); __builtin_amdgcn_sched_barrier(0); ATT_VWAIT();
                  ATT_VRD(va, vad2); __builtin_amdgcn_sched_barrier(0); ATT_PV(1, vbq); __builtin_amdgcn_sched_barrier(0); ATT_VWAIT();
                  ATT_VRD(vbq, vad3); __builtin_amdgcn_sched_barrier(0); ATT_PV(2, va); __builtin_amdgcn_sched_barrier(0); ATT_VWAIT();
                  ATT_PV(3, vbq); __builtin_amdgcn_sched_barrier(0);
#undef ATT_VRD
#undef ATT_VWAIT
#undef ATT_PV
                }
              }
            }
        }
        if (NBUF == 3 && staged) { if (bg_now) asm volatile("s_waitcnt vmcnt(11)" ::: "memory"); else asm volatile("s_waitcnt vmcnt(3)" ::: "memory"); }
        else { if (bg_now) asm volatile("s_waitcnt vmcnt(8)" ::: "memory"); else VM_WAIT(); }
#undef ATT_BGMID
        __syncthreads();
    }
    int lane_e = lane; asm volatile("" : "+v"(lane_e));
    LAS float* stg = (LAS float*)(lds + wid * STG_WAVE);
    { const int r32 = lane_e & 31, hi = lane_e >> 5;
      if (MODE == 0) {
        LAS float* wsf2 = (LAS float*)(lds + 8 * STG_WAVE) + wid * 64;
        float l0 = lsum[0], l1 = lsum[NMAP - 1];
        { auto rr = __builtin_amdgcn_permlane32_swap(__float_as_uint(l0), __float_as_uint(l0), false, false); l0 = __uint_as_float(rr[0]) + __uint_as_float(rr[1]); }
        { auto rr = __builtin_amdgcn_permlane32_swap(__float_as_uint(l1), __float_as_uint(l1), false, false); l1 = __uint_as_float(rr[0]) + __uint_as_float(rr[1]); }
        if (hi == 0) { wsf2[r32] = 1.0f / l0; wsf2[32 + r32] = -A.lam / l1; }
        LDS_WAIT();
#pragma unroll
        for (int r = 0; r < 16; ++r) { const float a0 = wsf2[crow(r, hi)], a1 = wsf2[32 + crow(r, hi)];
#pragma unroll
            for (int d = 0; d < 4; ++d) stg[crow(r, hi) * STG_PITCH + d * 32 + r32] = o[0][d][r] * a0 + o[NMAP - 1][d][r] * a1; }
      } else {
#pragma unroll
        for (int r = 0; r < 16; ++r)
#pragma unroll
            for (int d = 0; d < 4; ++d) stg[crow(r, hi) * STG_PITCH + d * 32 + r32] = o[0][d][r];
      }
    }
    LDS_WAIT();
    const int c8 = lane_e & 15;
#pragma unroll
    for (int ps = 0; ps < 8; ++ps) {
        const int row = 4 * ps + (lane_e >> 4);
        const f32x4 va = *(const LAS f32x4*)(stg + row * STG_PITCH + 8 * c8), vb4 = *(const LAS f32x4*)(stg + row * STG_PITCH + 8 * c8 + 4);
        float v[8] = {va[0], va[1], va[2], va[3], vb4[0], vb4[1], vb4[2], vb4[3]};
        const size_t tok = rowbase + qw + row;
        float ov[8];
        if (MODE == 0) {
            float ss = 0.f;
#pragma unroll
            for (int j = 0; j < 8; ++j) ss += v[j] * v[j];
            ss += __shfl_xor(ss, 1); ss += __shfl_xor(ss, 2); ss += __shfl_xor(ss, 4); ss += __shfl_xor(ss, 8);
            const float rn = 0.8f / sqrtf(ss * (1.0f / 128.0f) + EPS);
            const f32x4 g0 = *(const f32x4*)(A.subln_g + 8 * c8), g1 = *(const f32x4*)(A.subln_g + 8 * c8 + 4);
#pragma unroll
            for (int j = 0; j < 4; ++j) { ov[j] = v[j] * rn * g0[j]; ov[4 + j] = v[4 + j] * rn * g1[j]; }
        } else {
            float s1 = 0.f;
#pragma unroll
            for (int j = 0; j < 8; ++j) s1 += v[j];
            s1 += __shfl_xor(s1, 1); s1 += __shfl_xor(s1, 2); s1 += __shfl_xor(s1, 4); s1 += __shfl_xor(s1, 8);
            const float mu = s1 * (1.0f / 128.0f); float s2 = 0.f;
#pragma unroll
            for (int j = 0; j < 8; ++j) { v[j] -= mu; s2 += v[j] * v[j]; }
            s2 += __shfl_xor(s2, 1); s2 += __shfl_xor(s2, 2); s2 += __shfl_xor(s2, 4); s2 += __shfl_xor(s2, 8);
            const float rn = 1.0f / sqrtf(s2 * (1.0f / 128.0f) + EPS);
            const f32x4 g0 = *(const f32x4*)(A.gn_g + h * 128 + 8 * c8), g1 = *(const f32x4*)(A.gn_g + h * 128 + 8 * c8 + 4);
            const v4u gw = *(const v4u*)(A.proj + tok * NPROJ + C_RG + h * 128 + 8 * c8);
            float gt[8] = {bf2f(gw.x & 0xffff), bf2f(gw.x >> 16), bf2f(gw.y & 0xffff), bf2f(gw.y >> 16), bf2f(gw.z & 0xffff), bf2f(gw.z >> 16), bf2f(gw.w & 0xffff), bf2f(gw.w >> 16)};
#pragma unroll
            for (int j = 0; j < 8; ++j) { const float gg = (j < 4) ? g0[j] : g1[j - 4]; const float sl = gt[j] * __builtin_amdgcn_rcpf(1.0f + __builtin_amdgcn_exp2f(-gt[j] * LOG2E)); ov[j] = sl * (v[j] * rn * gg); }
        }
        v4u w; w.x = cvt_pk_bf16(ov[0], ov[1]); w.y = cvt_pk_bf16(ov[2], ov[3]); w.z = cvt_pk_bf16(ov[4], ov[5]); w.w = cvt_pk_bf16(ov[6], ov[7]);
        *(v4u*)(A.mix + tok * DM + (MODE == 0 ? 0 : 1024) + h * 128 + 8 * c8) = w;
    }
    LDS_WAIT(); __syncthreads();
}
#undef ATT_STAGE
#undef ATT_SRC
}

#define XB_TMO      128
#define XB_XCNT(j)  (256  + 64 * (j))
#define XB_XSUB(j)  (1280 + 64 * (j))
#define XB_XGEN(j)  (2304 + 64 * (j))
#define XB_TOP      3328
#define XB_TOPGEN   3392
#define XCD_BAR_WORDS 3456
#define XB_SPIN_CAP (1u << 18)
__device__ __forceinline__ unsigned xb_ld(unsigned* p)              { return __hip_atomic_load(p, __ATOMIC_RELAXED, __HIP_MEMORY_SCOPE_AGENT); }
__device__ __forceinline__ unsigned xb_add(unsigned* p, unsigned v) { return __hip_atomic_fetch_add(p, v, __ATOMIC_RELAXED, __HIP_MEMORY_SCOPE_AGENT); }
__device__ __forceinline__ unsigned xb_xcc_id() { return (unsigned)__builtin_amdgcn_s_getreg((3 << 11) | 20) & 0xFu; }
#define XB_SPIN(cond, bar) do { unsigned _sp = 0; while (cond) { __builtin_amdgcn_s_sleep(1); \
    if ((++_sp & 255u) == 0u) { if (xb_ld(&(bar)[XB_TMO])) break; if (_sp > XB_SPIN_CAP) { atomicAdd(&(bar)[XB_TMO], 1u); break; } } } } while (0)
struct XcdBarrier { unsigned* bar; unsigned x; volatile LAS unsigned* st; };
__device__ __forceinline__ XcdBarrier xcd_barrier_post(unsigned* bar, volatile LAS unsigned* st) {
    XcdBarrier b; b.bar = bar; b.x = xb_xcc_id(); b.st = st;
    if (threadIdx.x == 0) (void)xb_add(&bar[XB_XCNT(b.x)], 1u);
    return b;
}
__device__ __forceinline__ void xcd_barrier_complete(unsigned* bar, unsigned x, unsigned& nloc, unsigned& nx) {
    const unsigned G = gridDim.x * gridDim.y * gridDim.z;
    unsigned sum, cnt, mine, sp = 0u;
    for (;;) {
        sum = 0u; cnt = 0u; mine = 0u;
#pragma unroll
        for (unsigned j = 0; j < 16; ++j) { const unsigned c = xb_ld(&bar[XB_XCNT(j)]); sum += c; cnt += (c > 0u) ? 1u : 0u; mine = (j == x) ? c : mine; }
        if (sum == G) break;
        __builtin_amdgcn_s_sleep(1);
        if ((++sp & 255u) == 0u) { if (xb_ld(&bar[XB_TMO])) break; if (sp > XB_SPIN_CAP) { atomicAdd(&bar[XB_TMO], 1u); break; } }
    }
    nloc = mine > 0u ? mine : 1u; nx = cnt > 0u ? cnt : 1u;
}
__device__ __forceinline__ void xcd_barrier(const XcdBarrier& b) {
    asm volatile("s_waitcnt vmcnt(0)" ::: "memory");
    __syncthreads();
    if (threadIdx.x == 0) {
        unsigned* bar = b.bar;
        __builtin_amdgcn_s_waitcnt(0);
        unsigned nloc = b.st[0], nx = b.st[1];
        if (nloc == 0u) { xcd_barrier_complete(bar, b.x, nloc, nx); b.st[0] = nloc; b.st[1] = nx; }
        const unsigned old = xb_add(&bar[XB_XSUB(b.x)], 1u);
        const unsigned gen = old / nloc;
        if (old + 1u == (gen + 1u) * nloc) {
            __builtin_amdgcn_fence(__ATOMIC_RELEASE, "agent");
            asm volatile("s_waitcnt vmcnt(0)" ::: "memory");
            const unsigned og = xb_add(&bar[XB_TOP], 1u);
            const unsigned tg = og / nx;
            if (og + 1u == (tg + 1u) * nx) xb_add(&bar[XB_TOPGEN], 1u);
            else XB_SPIN(xb_ld(&bar[XB_TOPGEN]) == tg, bar);
            __builtin_amdgcn_fence(__ATOMIC_ACQUIRE, "agent");
            xb_add(&bar[XB_XGEN(b.x)], 1u);
            asm volatile("s_waitcnt vmcnt(0)" ::: "memory");
        } else {
            XB_SPIN(xb_ld(&bar[XB_XGEN(b.x)]) == gen, bar);
            __builtin_amdgcn_fence(__ATOMIC_ACQUIRE, "agent");
            asm volatile("s_waitcnt vmcnt(0)" ::: "memory");
        }
    }
    __syncthreads();
}

template <int MODE>
__device__ __forceinline__ int dest_row(int n) {
    if (MODE == 1) { if (n >= C_RQ && n < C_RV) { const int i = n & 63; return (n & ~63) + 2 * (i & 31) + (i >> 5); } return n; }
    if (MODE == 2) return 8 * (n >> 2) + (n & 3);
    if (MODE == 3) return 8 * (n >> 2) + 4 + (n & 3);
    return n;
}
template <int MODE>
__device__ __forceinline__ void p0_transpose_item(const float* W, int K, int N, bf16* WT, LAS float* scr, int item, int lane) {
    const int nblk = N / 32, kb = item / nblk, nb = item % nblk, k0 = 64 * kb, n0 = 32 * nb;
    float wv[32];
#pragma unroll
    for (int i = 0; i < 32; ++i) { const int kk = 2 * i + (lane >> 5); wv[i] = W[(size_t)(k0 + kk) * N + n0 + (lane & 31)]; }
#pragma unroll
    for (int i = 0; i < 32; ++i) { const int kk = 2 * i + (lane >> 5); scr[kk * 33 + (lane & 31)] = wv[i]; }
    LDS_WAIT(); asm volatile("" ::: "memory");
    const int c = lane & 7;
#pragma unroll
    for (int j = 0; j < 4; ++j) { const int n = (lane >> 3) + 8 * j; const LAS float* s = scr + (8 * c) * 33 + n;
        v4u o; o.x = pk2(s[0 * 33], s[1 * 33]); o.y = pk2(s[2 * 33], s[3 * 33]); o.z = pk2(s[4 * 33], s[5 * 33]); o.w = pk2(s[6 * 33], s[7 * 33]);
        *(GAS v4u*)(WT + (size_t)dest_row<MODE>(n0 + n) * K + k0 + 8 * c) = o; }
    LDS_WAIT(); asm volatile("" ::: "memory");
}

template <int MODE>
__device__ __forceinline__ void p0_direct_item(const float* W, int K, int N, bf16* WT, int item, int lane) {
    const int nblk = N / 32, kb = item / nblk, nb = item % nblk, n4 = lane & 7, kr = lane >> 3, k0 = 64 * kb + 8 * kr, n0 = 32 * nb + 4 * n4;
    const float* src = W + (size_t)k0 * N + n0;
    f32x4 r[8];
#pragma unroll
    for (int j = 0; j < 8; ++j) r[j] = *(const f32x4*)(src + (size_t)j * N);
#pragma unroll
    for (int i = 0; i < 4; ++i) { v4u w; w.x = pk2(r[0][i], r[1][i]); w.y = pk2(r[2][i], r[3][i]); w.z = pk2(r[4][i], r[5][i]); w.w = pk2(r[6][i], r[7][i]);
        *(GAS v4u*)(WT + (size_t)dest_row<MODE>(n0 + i) * K + k0) = w; }
}

struct KArgs { const float* in[20]; float* out; unsigned char* ws; int ph_lo, ph_hi; };

__global__ void __launch_bounds__(512, 2) hymba_fwd(KArgs args) {
    extern __shared__ __attribute__((aligned(16))) unsigned char lds_raw[];
    LAS unsigned char* lds = (LAS unsigned char*)lds_raw;
    volatile LAS unsigned* MISC = (volatile LAS unsigned*)(lds + MISC_OFF);
    LAS int* LTAB = (LAS int*)(lds + LTAB_OFF);
    const int tid = threadIdx.x, lane = tid & 63, wave = __builtin_amdgcn_readfirstlane(tid >> 6);
    const int G = gridDim.x; const int vcu = (G % 8 == 0) ? ((int)blockIdx.x % 8) * (G / 8) + (int)blockIdx.x / 8 : (int)blockIdx.x;
    const int gw = vcu * 8 + wave, NGW = G * 8;
    unsigned char* ws = args.ws;
    gu32* ctl = (gu32*)(ws + WS_CTL);
    const float* x = args.in[0]; const float* rel_bias = args.in[1]; const float* attn_norm_g = args.in[2]; const float* w_in = args.in[3];
    const float* lq1 = args.in[4]; const float* lk1 = args.in[5]; const float* lq2 = args.in[6]; const float* lk2 = args.in[7];
    const float* subln_g = args.in[8]; const float* gn_g = args.in[9]; const float* w_out = args.in[10]; const float* ffn_norm_g = args.in[11];
    const float* w_gr = args.in[12]; const float* b_group = args.in[13]; const float* w_ir = args.in[14]; const float* b_inner = args.in[15];
    const float* w_gate = args.in[16]; const float* w_up = args.in[17]; const float* w_down = args.in[18]; const float* final_g = args.in[19];
    float* out = args.out;
    f32x2* rope = (f32x2*)(ws + WS_ROPE); float* tbw = (float*)(ws + WS_TB);
    bf16* WRH = (bf16*)(ws + WS_WRH); bf16* WRL = (bf16*)(ws + WS_WRL);
    int* tok_e = (int*)(ws + WS_TOK + TOK_E); int* tok_rank = (int*)(ws + WS_TOK + TOK_RANK); float* irs1 = (float*)(ws + WS_TOK + TOK_GATE);
    float* tok_rs2 = (float*)(ws + WS_TOK + TOK_RS2); int* tok_pos = (int*)(ws + WS_TOK + TOK_POS); float* row_gate = (float*)(ws + WS_TOK + ROW_GATE);
    int* lst_tok = (int*)(ws + WS_LST); float* lst_rs = (float*)(ws + WS_LST + 2 * MiB); float* lst_gate = (float*)(ws + WS_LST + 4 * MiB);
    bf16* BTIN = (bf16*)(ws + WS_BTIN); bf16* BTOUT = (bf16*)(ws + WS_BTOUT); unsigned char* BTGU = ws + WS_BTGU; unsigned char* BTD = ws + WS_BTD;
    bf16* XN = (bf16*)(ws + WS_XN); bf16* MIX = (bf16*)(ws + WS_MIX); unsigned char* ACT = ws + WS_ACT;
    bf16* PROJ = (bf16*)(ws + WS_PROJ); unsigned char* XG = ws + WS_XG; unsigned char* Y = ws + WS_Y;
    bf16* X1 = (bf16*)(ws + WS_X1);

    for (int u = tid; u < (LDS_BYTES - LDSCTL_OFF) / 4; u += 512) ((LAS unsigned*)(lds + LDSCTL_OFF))[u] = 0u;
    __syncthreads();
    XcdBarrier bar; bar.bar = (unsigned*)(ctl + CW_BAR); bar.x = 0; bar.st = nullptr;
    if (N_LAUNCHES == 1) bar = xcd_barrier_post((unsigned*)(ctl + CW_BAR), MISC + 8);
    const int lo = args.ph_lo, hi_ph = args.ph_hi;
#ifndef PHASE_MASK
#define PHASE_MASK 0x1ff
#endif
#define IN(k) (((PHASE_MASK >> (k)) & 1) && lo <= (k) && (k) < hi_ph)
#ifndef PROBE_DUP
#define PROBE_DUP 0
#endif
#define REP(k) ((((PROBE_DUP) >> (k)) & 1) ? 2 : 1)
#define GRID_BAR(k) do { if (IN(k) && IN((k) + 1)) xcd_barrier(bar); } while (0)

    for (int rep_ = 0; rep_ < REP(0); ++rep_) if (IN(0)) {
        LAS float* scr = (LAS float*)(lds + RING_OFF + wave * 16384);
        constexpr int I_IN = (DM / 64) * (NPROJ / 32), I_OUT = (DM / 64) * (DM / 32);
        constexpr int NITEMS = I_IN + I_OUT;
        static_assert(BG_MODE == 3, "the expert weights are converted in the background of P2 only");
        for (int it = gw; it < NITEMS; it += NGW) {
            int r = it;
            if (r < I_IN) { p0_direct_item<1>(w_in, DM, NPROJ, BTIN, r, lane); continue; } r -= I_IN;
            p0_direct_item<0>(w_out, DM, DM, BTOUT, r, lane);
        }
        { const GAS f32x4* gr = (const GAS f32x4*)attn_norm_g + lane;
          f32x4 nx[8];
          if (gw < NTOK) { const GAS f32x4* xr = (const GAS f32x4*)(x + (size_t)gw * DM) + lane;
#pragma unroll
              for (int j = 0; j < 8; ++j) nx[j] = xr[64 * j]; }
          for (int m = gw; m < NTOK; m += NGW) {
            f32x4 v[8]; float s = 0.f;
#pragma unroll
            for (int j = 0; j < 8; ++j) { v[j] = nx[j]; s += (v[j].x * v[j].x + v[j].y * v[j].y) + (v[j].z * v[j].z + v[j].w * v[j].w); }
            if (m + NGW < NTOK) { const GAS f32x4* xr = (const GAS f32x4*)(x + (size_t)(m + NGW) * DM) + lane;
#pragma unroll
                for (int j = 0; j < 8; ++j) nx[j] = xr[64 * j]; }
            const float srt = sqrtf(wave_sum(s) * (1.0f / DM) + EPS), rs = 1.0f / srt;
            if (lane == 0) irs1[m] = srt;
            GAS unsigned long long* o8 = (GAS unsigned long long*)(XN + (size_t)m * DM) + lane;
#pragma unroll
            for (int j = 0; j < 8; ++j) { const f32x4 g = gr[64 * j]; o8[64 * j] = (unsigned long long)pk2(v[j].x * rs * g.x, v[j].y * rs * g.y) | ((unsigned long long)pk2(v[j].z * rs * g.z, v[j].w * rs * g.w) << 32); }
          }
        }
        for (int i = blockIdx.x * 512 + tid; i < SEQ * 32; i += G * 512) { const int pos = i >> 5, t = i & 31;
            const float f = __builtin_amdgcn_exp2f(-(float)t * (13.287712379549449f / 32.0f));
            double rev = (double)((float)pos * f) * 0.15915494309189535; rev -= __builtin_rint(rev);
            rope[i] = (f32x2){__builtin_amdgcn_cosf((float)rev), __builtin_amdgcn_sinf((float)rev)}; }
        for (int i = blockIdx.x * 512 + tid; i < 8 * 304; i += G * 512) { const int hh = i / 304, d = 207 - (i % 304); int bkt;
            if (d < 16) bkt = d < 0 ? 0 : d; else { const float lr = __logf((float)d / 16.0f) / 2.0794415416798357f; bkt = 16 + (int)(lr * 16.0f); bkt = bkt > 31 ? 31 : bkt; }
            tbw[i] = rel_bias[bkt * 8 + hh] * LOG2E; }
        for (int i = blockIdx.x * 512 + tid; i < 48 * DM; i += G * 512) { const int c = i / DM, k = i % DM; float w = 0.f;
            if (c < 4) w = w_gr[k * 4 + c]; else if (c < 36) { const int gq = (c - 4) >> 3, e = (c - 4) & 7; w = w_ir[((size_t)gq * DM + k) * 8 + e]; }
            const unsigned hb = f2bf(w); WRH[i] = (bf16)hb; WRL[i] = (bf16)f2bf(w - bf2f((unsigned short)hb)); }
    }
    GRID_BAR(0);

    if (IN(1)) {
        pg8::Gemm g{XN, BTIN, DM * 2, 0, nullptr}; pg8::StaticOrder S; S.init(NTOK, NPROJ, G, (int)blockIdx.x, REP(1));
        pg8::EpiProj E{PROJ, rope};
        pg8::gemm_phase<pg8::EpiProj, pg8::StaticOrder>(lds + RING_OFF, g, S, E);
    }
    GRID_BAR(1);

    if (IN(2)) {
        float s1 = 0.f, s2 = 0.f;
        if (lane < 64) { s1 = lq1[lane] * lk1[lane]; s2 = lq2[lane] * lk2[lane]; }
        s1 = wave_sum(s1); s2 = wave_sum(s2);
        const float lam = __expf(s1) - __expf(s2) + 0.2f;
        att::Args A{PROJ, MIX, tbw, subln_g, gn_g, lam};
        att::Bg BG; BG.wg = w_gate; BG.wu = w_up; BG.wd = w_down; BG.btgu = BTGU; BG.btd = BTD; BG.have = false;
        { constexpr int NBG = NEXP * 3 * 1024; const int per = (NBG + NGW - 1) / NGW; BG.it = gw * per; BG.end = BG.it + per < NBG ? BG.it + per : NBG; if (BG.it > NBG) BG.it = NBG; }
#pragma unroll
        for (int j = 0; j < 8; ++j) BG.r[j] = (f32x4){0.f, 0.f, 0.f, 0.f};
        for (int it0 = vcu; it0 < 256 * REP(2); it0 += G) { const int it = it0 & 255;
            const int bh = it >> 2, s = it & 3, b = bh >> 3, h = bh & 7;
            for (int i = 0; i < 2; ++i) { const int qb = i ? s : 7 - s;
#ifndef NO_M0
                att::attn_unit<0>(A, BG, b, h, qb, lds);
#endif
#ifndef NO_M1
                att::attn_unit<1>(A, BG, b, h, qb, lds);
#endif
            }
        }
        for (;;) { att::bg_retire(BG, lane); if (BG.it >= BG.end) break; att::bg_issue(BG, lane); }
    }
    GRID_BAR(2);

    if (IN(3)) {
        pg8::Gemm g{MIX, BTOUT, DM * 2, 0, nullptr}; pg8::StaticOrder S; S.init(NTOK, DM, G, (int)blockIdx.x, REP(3));
        pg8::EpiRes E{XN, irs1, attn_norm_g, X1, XG, ffn_norm_g};
        pg8::gemm_phase<pg8::EpiRes, pg8::StaticOrder>(lds + RING_OFF, g, S, E);
    }
    GRID_BAR(3);

    if (IN(4)) {
        LAS float* lgp = (LAS float*)(lds + RING_OFF) + (wave >> 1) * 2048;
        const int r = lane & 15, q4 = lane >> 4, kh = wave & 1;
        for (int tile = gw >> 1; tile < NTOK / 16; tile += NGW / 2) {
            const int t0 = tile * 16;
            f32x4 acc[3]; float ss;
            for (int rep4_ = 0; rep4_ < REP(4); ++rep4_) {
            acc[0] = (f32x4){0.f, 0.f, 0.f, 0.f}; acc[1] = acc[0]; acc[2] = acc[0]; ss = 0.f;
            const bf16* xrow = X1 + (size_t)(t0 + r) * DM + kh * 1024 + 8 * q4;
            const float* grow = ffn_norm_g + kh * 1024 + 8 * q4;
            unsigned char* xgrow = XG + (size_t)(t0 + r) * DM + kh * 1024 + 8 * q4;
            const bf16* wh = WRH + (size_t)r * DM + kh * 1024 + 8 * q4; const bf16* wl = WRL + (size_t)r * DM + kh * 1024 + 8 * q4;
#pragma unroll 8
            for (int k0 = 0; k0 < 1024; k0 += 32) {
                const v4u xw = *(const v4u*)(xrow + k0);
                const f32x4 xa = (f32x4){bf2f(xw.x & 0xffff), bf2f(xw.x >> 16), bf2f(xw.y & 0xffff), bf2f(xw.y >> 16)}, xb = (f32x4){bf2f(xw.z & 0xffff), bf2f(xw.z >> 16), bf2f(xw.w & 0xffff), bf2f(xw.w >> 16)};
                const f32x4 ga = *(const f32x4*)(grow + k0), gb = *(const f32x4*)(grow + k0 + 4);
                float hv[8] = {xa[0] * ga[0], xa[1] * ga[1], xa[2] * ga[2], xa[3] * ga[3], xb[0] * gb[0], xb[1] * gb[1], xb[2] * gb[2], xb[3] * gb[3]};
                ss += (xa[0] * xa[0] + xa[1] * xa[1]) + (xa[2] * xa[2] + xa[3] * xa[3]) + (xb[0] * xb[0] + xb[1] * xb[1]) + (xb[2] * xb[2] + xb[3] * xb[3]);
                unsigned hb[8], lb[8];
#pragma unroll
                for (int j = 0; j < 8; ++j) { hb[j] = f2bf(hv[j]); lb[j] = f2bf(hv[j] - bf2f((unsigned short)hb[j])); }
                const v4u ahw = (v4u){hb[0] | (hb[1] << 16), hb[2] | (hb[3] << 16), hb[4] | (hb[5] << 16), hb[6] | (hb[7] << 16)};
                const v4u alw = (v4u){lb[0] | (lb[1] << 16), lb[2] | (lb[3] << 16), lb[4] | (lb[5] << 16), lb[6] | (lb[7] << 16)};
                { v2u q; q.x = pk4_fp8(hv[0], hv[1], hv[2], hv[3]); q.y = pk4_fp8(hv[4], hv[5], hv[6], hv[7]); *(v2u*)(xgrow + k0) = q; }
                const bf16x8 ah = __builtin_bit_cast(bf16x8, ahw), al = __builtin_bit_cast(bf16x8, alw);
#pragma unroll
                for (int cb = 0; cb < 3; ++cb) {
                    const bf16x8 bh = *(const bf16x8*)(wh + (size_t)cb * 16 * DM + k0), bl = *(const bf16x8*)(wl + (size_t)cb * 16 * DM + k0);
                    acc[cb] = __builtin_amdgcn_mfma_f32_16x16x32_bf16(ah, bh, acc[cb], 0, 0, 0);
                    acc[cb] = __builtin_amdgcn_mfma_f32_16x16x32_bf16(al, bh, acc[cb], 0, 0, 0);
                    acc[cb] = __builtin_amdgcn_mfma_f32_16x16x32_bf16(ah, bl, acc[cb], 0, 0, 0);
                }
            }
            }
            ss += __shfl_xor(ss, 16); ss += __shfl_xor(ss, 32);
            if (kh == 1) {
#pragma unroll
                for (int cb = 0; cb < 3; ++cb)
#pragma unroll
                    for (int i = 0; i < 4; ++i) lgp[1024 + lane * 13 + cb * 4 + i] = acc[cb][i];
                lgp[1024 + lane * 13 + 12] = ss;
            }
            __syncthreads();
            if (kh == 0) {
#pragma unroll
                for (int cb = 0; cb < 3; ++cb)
#pragma unroll
                    for (int i = 0; i < 4; ++i) lgp[(4 * q4 + i) * 48 + cb * 16 + r] = acc[cb][i] + lgp[1024 + lane * 13 + cb * 4 + i];
                ss += lgp[1024 + lane * 13 + 12];
                const float rs2 = 1.0f / sqrtf(ss * (1.0f / DM) + EPS);
                LDS_WAIT(); asm volatile("" ::: "memory");
                if (lane < 16) {
                    const LAS float* L = lgp + lane * 48; const int tok = t0 + lane;
                    float gl[4]; int gi = 0; float gmx = -INFINITY;
#pragma unroll
                    for (int g = 0; g < 4; ++g) { gl[g] = rs2 * L[g] + b_group[g]; if (gl[g] > gmx) { gmx = gl[g]; gi = g; } }
                    float den = 0.f;
#pragma unroll
                    for (int g = 0; g < 4; ++g) den += __expf(gl[g] - gmx);
                    const float pg = 1.0f / den;
                    int i0 = 0, i1 = 0; float v0 = -INFINITY, v1 = -INFINITY;
#pragma unroll
                    for (int e = 0; e < 8; ++e) { const float v = rs2 * L[4 + 8 * gi + e] + b_inner[gi * 8 + e]; if (v > v0) { v1 = v0; i1 = i0; v0 = v; i0 = e; } else if (v > v1) { v1 = v; i1 = e; } }
                    const float w0 = 1.0f / (1.0f + __expf(v1 - v0)), w1 = 1.0f - w0;
                    const int e0 = 8 * gi + i0, e1 = 8 * gi + i1;
                    const int rk0 = (int)__hip_atomic_fetch_add((unsigned*)(ctl + CW_CNT + 16 * e0), 1u, RLX_AGENT);
                    const int rk1 = (int)__hip_atomic_fetch_add((unsigned*)(ctl + CW_CNT + 16 * e1), 1u, RLX_AGENT);
                    tok_e[2 * tok] = e0; tok_e[2 * tok + 1] = e1; tok_rank[2 * tok] = rk0; tok_rank[2 * tok + 1] = rk1;
                    lst_tok[e0 * pg8::LCAP + rk0] = tok; lst_rs[e0 * pg8::LCAP + rk0] = rs2; lst_gate[e0 * pg8::LCAP + rk0] = pg * w0;
                    lst_tok[e1 * pg8::LCAP + rk1] = tok; lst_rs[e1 * pg8::LCAP + rk1] = rs2; lst_gate[e1 * pg8::LCAP + rk1] = pg * w1;
                }
            }
            LDS_WAIT(); __syncthreads();
        }
    }
    GRID_BAR(4);

    if (IN(6) || IN(7) || IN(8)) {
        if (tid == 0) { int off = 0, nt = 0;
            for (int e = 0; e < NEXP; ++e) { const int c = (int)__hip_atomic_load((unsigned*)(ctl + CW_CNT + 16 * e), RLX_AGENT); const int pc = (c + 255) >> 8;
                LTAB[e] = off; LTAB[96 + e] = c; for (int i = 0; i < pc; ++i) LTAB[128 + nt + i] = e; nt += pc; off += pc * 256; }
            LTAB[32] = nt; }
        __syncthreads();
    }
    {
        const int U = LTAB[32] * 8, R = U / G, rem = U - R * G, E = G - rem;
        const bool mixed = (FORCE_NOMIX == 0) && (N_LAUNCHES == 1) && IN(6) && IN(7) && R >= 1 && rem > 0 && 2 * rem <= G && (PROBE_DUP & 0xC0) == 0;
        const pg8::Gemm g6{XG, BTGU, DM, (size_t)2048 * DM, lst_tok}; const pg8::EpiSwiglu E6{ACT, lst_rs};
        const pg8::Gemm g7{ACT, BTD, FF, (size_t)DM * FF, nullptr}; const pg8::EpiDown E7{Y, lst_gate};
        if (mixed) {
            { pg8::GroupOrder S{LTAB[32], 8, G, vcu, LTAB, 0, R * G}; pg8::gemm_phase<pg8::EpiSwiglu, pg8::GroupOrder, true, true, 122, 127>(lds + RING_OFF, g6, S, E6); }
            xcd_barrier(bar);
            if (vcu < rem) { pg8::GroupOrder S{LTAB[32], 8, G, vcu, LTAB, R * G, U}; pg8::gemm_phase<pg8::EpiSwiglu, pg8::GroupOrder, true, true, 122, 127>(lds + RING_OFF, g6, S, E6); }
            else { pg8::GroupOrder S{LTAB[32], 8, G, vcu, LTAB, -rem, E}; pg8::gemm_phase<pg8::EpiDown, pg8::GroupOrder, false, true, 122, 127>(lds + RING_OFF, g7, S, E7); }
            xcd_barrier(bar);
            { pg8::GroupOrder S{LTAB[32], 8, G, vcu, LTAB, E, U}; pg8::gemm_phase<pg8::EpiDown, pg8::GroupOrder, false, true, 122, 127>(lds + RING_OFF, g7, S, E7); }
        } else {
            for (int rep_ = 0; rep_ < REP(6); ++rep_) if (IN(6)) { pg8::GroupOrder S{LTAB[32], 8, G, vcu, LTAB, 0, U}; pg8::gemm_phase<pg8::EpiSwiglu, pg8::GroupOrder, true, true, 122, 127>(lds + RING_OFF, g6, S, E6); }
            GRID_BAR(6);
            for (int rep_ = 0; rep_ < REP(7); ++rep_) if (IN(7)) { pg8::GroupOrder S{LTAB[32], 8, G, vcu, LTAB, 0, U}; pg8::gemm_phase<pg8::EpiDown, pg8::GroupOrder, false, true, 122, 127>(lds + RING_OFF, g7, S, E7); }
        }
    }
    GRID_BAR(7);

    for (int rep_ = 0; rep_ < REP(8); ++rep_) if (IN(8)) {
        unsigned poison = (__hip_atomic_load(ctl + CW_BAR + XB_TMO, RLX_AGENT) != 0u);
        int myd0 = 0, myd1 = 0;
        { const int m = gw + lane * NGW; if (m < NTOK) { myd0 = LTAB[tok_e[2 * m]] + tok_rank[2 * m]; myd1 = LTAB[tok_e[2 * m + 1]] + tok_rank[2 * m + 1]; } }
        const GAS f32x4* gr = (const GAS f32x4*)final_g + lane;
        v2u xv[8]; unsigned ya[8], yc[8];
#define P8_LOAD(i_) do { const int m_ = gw + (i_) * NGW; const int d0_ = __shfl(myd0, (i_)), d1_ = __shfl(myd1, (i_)); \
            const GAS v2u* xr_ = (const GAS v2u*)(X1 + (size_t)m_ * DM) + lane; const GAS unsigned* y0_ = (const GAS unsigned*)(Y + (size_t)d0_ * DM) + lane; const GAS unsigned* y1_ = (const GAS unsigned*)(Y + (size_t)d1_ * DM) + lane; \
            _Pragma("unroll") for (int j = 0; j < 8; ++j) { xv[j] = xr_[64 * j]; ya[j] = y0_[64 * j]; yc[j] = y1_[64 * j]; } } while (0)
        if (gw < NTOK) P8_LOAD(0);
        for (int i = 0, m = gw; m < NTOK; m += NGW, ++i) {
            f32x4 v[8]; float s = 0.f;
#pragma unroll
            for (int j = 0; j < 8; ++j) { const int a = (int)ya[j], c = (int)yc[j]; constexpr float iy = 1.0f / YSCALE;
                v[j].x = bf2f(xv[j].x & 0xffff) + (__builtin_amdgcn_cvt_f32_fp8(a, 0) + __builtin_amdgcn_cvt_f32_fp8(c, 0)) * iy; v[j].y = bf2f(xv[j].x >> 16) + (__builtin_amdgcn_cvt_f32_fp8(a, 1) + __builtin_amdgcn_cvt_f32_fp8(c, 1)) * iy;
                v[j].z = bf2f(xv[j].y & 0xffff) + (__builtin_amdgcn_cvt_f32_fp8(a, 2) + __builtin_amdgcn_cvt_f32_fp8(c, 2)) * iy; v[j].w = bf2f(xv[j].y >> 16) + (__builtin_amdgcn_cvt_f32_fp8(a, 3) + __builtin_amdgcn_cvt_f32_fp8(c, 3)) * iy;
                s += (v[j].x * v[j].x + v[j].y * v[j].y) + (v[j].z * v[j].z + v[j].w * v[j].w); }
            if (m + NGW < NTOK) P8_LOAD(i + 1);
            float rs = 1.0f / sqrtf(wave_sum(s) * (1.0f / DM) + EPS);
            if (poison) rs = __builtin_nanf("");
            GAS f32x4* orow = (GAS f32x4*)(out + (size_t)m * DM) + lane;
#pragma unroll
            for (int j = 0; j < 8; ++j) { const f32x4 g = gr[64 * j]; orow[64 * j] = (f32x4){v[j].x * rs * g.x, v[j].y * rs * g.y, v[j].z * rs * g.z, v[j].w * rs * g.w}; }
        }
#undef P8_LOAD
    }
#undef IN
#undef GRID_BAR
}

extern "C" void kernel_launch(void* const* d_in, const int* in_sizes, int n_in, void* d_out, int out_size, void* d_ws, size_t ws_size, hipStream_t stream) {
    static int grid = 0;
    if (grid == 0) {
        if (n_in != 20 || in_sizes[0] != NTOK * DM || out_size != NTOK * DM || ws_size < WS_END) {
            fprintf(stderr, "kernel_launch: unexpected shapes: n_in %d in0 %d out %d ws %zu (need %zu); nothing launched\n", n_in, n_in > 0 ? in_sizes[0] : -1, out_size, ws_size, (size_t)WS_END); grid = -1; return; }
        int dev = 0, cus = 0, per_cu = 0;
        if (hipGetDevice(&dev) != hipSuccess || hipDeviceGetAttribute(&cus, hipDeviceAttributeMultiprocessorCount, dev) != hipSuccess) { fprintf(stderr, "kernel_launch: device query failed\n"); grid = -1; return; }
        if (hipFuncSetAttribute((const void*)hymba_fwd, hipFuncAttributeMaxDynamicSharedMemorySize, LDS_BYTES) != hipSuccess) { fprintf(stderr, "kernel_launch: hipFuncSetAttribute failed\n"); grid = -1; return; }
        if (hipOccupancyMaxActiveBlocksPerMultiprocessor(&per_cu, (const void*)hymba_fwd, 512, LDS_BYTES) != hipSuccess || per_cu < 1) {
            fprintf(stderr, "kernel_launch: occupancy query reports %d workgroups per CU\n", per_cu); per_cu = 1; }
        (void)hipGetLastError();
        grid = cus;
    }
    if (grid < 0) return;
    if (hipMemsetAsync((char*)d_ws + WS_CTL, 0, CTL_ZERO_BYTES, stream) != hipSuccess) { fprintf(stderr, "kernel_launch: memset failed\n"); return; }
    KArgs a{};
    for (int i = 0; i < 20; ++i) a.in[i] = (const float*)d_in[i];
    a.out = (float*)d_out; a.ws = (unsigned char*)d_ws;
    for (int li = 0; li < N_LAUNCHES; ++li) {
        a.ph_lo = (N_LAUNCHES == 1) ? 0 : li; a.ph_hi = (N_LAUNCHES == 1) ? N_PHASES : li + 1;
        hipLaunchKernelGGL(hymba_fwd, dim3(grid), dim3(512), LDS_BYTES, stream, a);
        const hipError_t le = hipPeekAtLastError();
        if (le != hipSuccess) { fprintf(stderr, "kernel_launch: launch %d failed: %s\n", li, hipGetErrorName(le)); break; }
    }
}
```

```cpp
#include <hip/hip_runtime.h>
#include <cstdio>
#include <cstdint>
#include <type_traits>

#ifndef BG_MODE
#define BG_MODE 3
#endif
#ifndef FORCE_NOMIX
#define FORCE_NOMIX 0
#endif
#ifndef MK_N_LAUNCHES
#define MK_N_LAUNCHES 1
#endif
constexpr int N_PHASES = 9;
constexpr int N_LAUNCHES = MK_N_LAUNCHES;

constexpr int BATCH = 8, SEQ = 2048, DM = 2048, NTOK = BATCH * SEQ;
constexpr int NPROJ = 6144;
constexpr int C_DQ = 0, C_DK = 1024, C_DV = 2048, C_RQ = 3072, C_RK = 3584, C_RV = 4096, C_RG = 5120;
constexpr int NEXP = 32, FF = 1024;
constexpr int XS_ROWS = 40960;
constexpr float EPS = 1e-6f;
constexpr float LOG2E = 1.4426950408889634f;
constexpr float YSCALE = 16.0f;
constexpr float QSCALE = 0.125f * LOG2E;

constexpr size_t MiB = 1u << 20;
constexpr size_t WS_CTL = 0, CTL_ZERO_BYTES = 1 * MiB;
constexpr size_t WS_ROPE = 1 * MiB;
constexpr size_t WS_TB = 1 * MiB + 512 * 1024;
constexpr size_t WS_WRH = 2 * MiB, WS_WRL = 2 * MiB + 256 * 1024;
constexpr size_t WS_TOK = 3 * MiB;
constexpr size_t TOK_E = 0, TOK_RANK = 128 * 1024, TOK_GATE = 256 * 1024, TOK_RS2 = 384 * 1024, TOK_POS = 448 * 1024, ROW_GATE = 576 * 1024, ROW_RS = 736 * 1024;
constexpr size_t WS_SROW = 2 * MiB + 512 * 1024;
constexpr size_t WS_BTIN = 4 * MiB, WS_BTOUT = 28 * MiB, WS_BTGU = 36 * MiB, WS_BTD = 292 * MiB;
constexpr size_t WS_XN = 420 * MiB, WS_MIX = 484 * MiB, WS_ACT = 420 * MiB;
constexpr size_t WS_PROJ = 548 * MiB, WS_Y = 548 * MiB, WS_XG = 708 * MiB;
constexpr size_t WS_X1 = 772 * MiB, WS_LST = 840 * MiB, WS_END = 900 * MiB;
constexpr int CW_TMO = 0, CW_CODE = 1, CW_BAR = 4096, CW_CNT = 16384;

constexpr int RING_OFF = 0, RING_BYTES = 131072;
constexpr int LDSCTL_OFF = 139264, MISC_OFF = LDSCTL_OFF + 320;
constexpr int LTAB_OFF = LDSCTL_OFF + 1024;
constexpr int LDS_BYTES = 147456;

#define GAS __attribute__((address_space(1)))
#define LAS __attribute__((address_space(3)))
typedef unsigned short bf16;
typedef unsigned v4u __attribute__((ext_vector_type(4)));
typedef unsigned v2u __attribute__((ext_vector_type(2)));
typedef float f32x4 __attribute__((ext_vector_type(4)));
typedef float f32x2 __attribute__((ext_vector_type(2)));
typedef float f32x16 __attribute__((ext_vector_type(16)));
typedef short bf16x8 __attribute__((ext_vector_type(8)));
typedef short s16x4 __attribute__((ext_vector_type(4)));
typedef GAS unsigned gu32;
#define RLX_AGENT __ATOMIC_RELAXED, __HIP_MEMORY_SCOPE_AGENT
#define LDS_WAIT() asm volatile("s_waitcnt lgkmcnt(0)" ::: "memory")
#define VM_WAIT() asm volatile("s_waitcnt vmcnt(0)" ::: "memory")

__device__ __forceinline__ unsigned f2bf(float f) { unsigned u = __builtin_bit_cast(unsigned, f); return (u + 0x7fffu + ((u >> 16) & 1u)) >> 16; }
__device__ __forceinline__ unsigned pk2(float lo, float hi) { return f2bf(lo) | (f2bf(hi) << 16); }
__device__ __forceinline__ float bf2f(unsigned short b) { return __builtin_bit_cast(float, (unsigned)b << 16); }
__device__ __forceinline__ unsigned cvt_pk_bf16(float lo, float hi) { unsigned r; asm volatile("v_cvt_pk_bf16_f32 %0, %1, %2" : "=v"(r) : "v"(lo), "v"(hi)); return r; }
__device__ __forceinline__ unsigned pk4_fp8(float a, float b, float c, float d) { unsigned w = 0u; w = (unsigned)__builtin_amdgcn_cvt_pk_fp8_f32(a, b, (int)w, false); w = (unsigned)__builtin_amdgcn_cvt_pk_fp8_f32(c, d, (int)w, true); return w; }
__device__ __forceinline__ float wave_sum(float v) {
#pragma unroll
    for (int o = 1; o < 64; o <<= 1) v += __shfl_xor(v, o);
    return v;
}

#ifndef TPROBE
#define TPROBE 0
#endif
#ifndef TPHASE
#define TPHASE 8
#endif
#ifndef TAMP
#define TAMP 8
#endif
#ifndef TBLK
#define TBLK 0
#endif
#define TP_T() ((long long)__builtin_amdgcn_s_memrealtime())
namespace pg8 {
#define PG8_LAS __attribute__((address_space(3)))
typedef unsigned short bf16_t;
typedef int v4i_t __attribute__((ext_vector_type(4)));
typedef int v8i_t __attribute__((ext_vector_type(8)));
constexpr int LCAP = 16384;
constexpr int BM = 256, BK = 64, HALF = 128, HTB = HALF * BK * 2, STAGE_BYTES = 8 * HTB, NXCD = 8, WGM = 8;
__host__ __device__ __forceinline__ int lds_byte(int r, int c) { const int st = (r >> 4) * 2 + (c >> 5), rr = r & 15, cc = c & 31, ob = rr * 64 + cc * 2; return st * 1024 + (ob ^ (((ob >> 9) & 1) << 5)); }
__host__ __device__ __forceinline__ void stage_rc(int b, int& R, int& C) { const int st = b / 1024, sb = b % 1024, swz = sb ^ (((sb >> 9) & 1) << 5); R = (st >> 1) * 16 + swz / 64; C = (st & 1) * 32 + (swz % 64) / 2; }
__host__ __device__ __forceinline__ int perm32(int rho) { const int n = rho >> 4, i = rho & 15; return 8 * (i >> 2) + 4 * n + (i & 3); }

struct Unit { int pm, pn, e, rl0, cnt; };
struct Gemm { const void* A; const void* Bt; int Kb; size_t bstride; const int* lst; };

struct StaticOrder {
    int nM, nN, nwg, G, c;
    int reps;
    __device__ void init(int M, int N, int G_, int c_, int reps_ = 1) { nM = M / BM; nN = N / BM; nwg = nM * nN; G = G_; c = c_; reps = reps_; }
    __device__ bool next(int i, Unit& u) const {
        const long L0 = (long)i * G + c; if (L0 >= (long)nwg * reps) return false;
        const long L = L0 % nwg;
        int wgid = (int)L; { const int q = nwg / NXCD, r = nwg % NXCD, xcd = wgid % NXCD, off = wgid / NXCD; wgid = (xcd < r ? xcd * (q + 1) : r * (q + 1) + (xcd - r) * q) + off; }
        const int nig = WGM * nN, gid = wgid / nig, fm = gid * WGM, gsz = (nM - fm) < WGM ? (nM - fm) : WGM;
        u.pm = fm + ((wgid % nig) % gsz); u.pn = (wgid % nig) / gsz; u.e = 0; u.rl0 = 0; u.cnt = 0; return true;
    }
};
struct GroupOrder {
    int ntiles, nN, G, c; const PG8_LAS int* tab;
    int L0, Lend;
    __device__ bool next(int i, Unit& u) const {
        const int L = L0 + i * G + c; if (L < 0 || L >= Lend) return false;
        const int t = L / nN; u.pm = t; u.pn = L - t * nN; u.e = __builtin_amdgcn_readfirstlane(tab[128 + t]);
        u.rl0 = t * BM - __builtin_amdgcn_readfirstlane(tab[u.e]); u.cnt = __builtin_amdgcn_readfirstlane(tab[96 + u.e]); return true;
    }
};

template <class Epi, class Sched, bool GATHER = false, bool F8 = false, int SA = 127, int SB = 127>
__device__ __forceinline__ void gemm_phase(PG8_LAS unsigned char* lds, const Gemm g, const Sched& S, const Epi& E, long long& tacc) {
#if TPROBE == 3
    const long long tp_entry = TP_T();
#endif
#if TPROBE
    long long tp_a = 0;
#endif
    const int tid = threadIdx.x, wid = __builtin_amdgcn_readfirstlane(tid >> 6), lane = tid & 63, wr = wid >> 2, wc = wid & 3, fr = lane & 15, fq = lane >> 4;
    const int Kb = g.Kb, nt = Kb / 128;
    unsigned voffA[2], voffB[2];
#pragma unroll
    for (int i = 0; i < 2; ++i) { int R, C; stage_rc(tid * 16 + i * 8192, R, C); const int Rb = Epi::PERM ? ((R & ~31) + perm32(R & 31)) : R;
        voffA[i] = (unsigned)(R * Kb + C * 2); voffB[i] = (unsigned)(Rb * Kb + C * 2); }
    unsigned vC[2][2], vN[2][2];
#define PG8_GOFF(dst, u_) do { _Pragma("unroll") for (int _h = 0; _h < 2; ++_h) _Pragma("unroll") for (int _i = 0; _i < 2; ++_i) { int R_, C_; stage_rc(tid * 16 + _i * 8192, R_, C_); \
        const int rl_ = (u_).rl0 + _h * HALF + R_; const int tk_ = rl_ < (u_).cnt ? g.lst[(u_).e * LCAP + rl_] : 0; dst[_h][_i] = (unsigned)(tk_ * Kb + C_ * 2); } } while (0)
    const size_t kstep = (size_t)(BK * 2);
    const size_t hstep = (size_t)HALF * Kb;
    const size_t tstep = 2 * hstep;
    const unsigned ldsw = (unsigned)wid * 1024u;
    const int aoff = lds_byte(wr * 64 + fr, fq * 8), boff = lds_byte(wc * 32 + fr, fq * 8);
#define PG8_SA(b, h) (((b) * 2 + (h)) * HTB)
#define PG8_SB(b, h) ((4 + (b) * 2 + (h)) * HTB)
#define PG8_STAGE(bufoff, gbase, voff) do { _Pragma("unroll") for (int _i = 0; _i < 2; ++_i) \
        __builtin_amdgcn_global_load_lds((const unsigned*)((const char*)(gbase) + (voff)[_i]), (PG8_LAS unsigned*)(lds + (bufoff) + ldsw + _i * 8192), 16, 0, 0); } while (0)
#define PG8_STAGE_A(bufoff, gbase, hh, nx) do { if constexpr (GATHER) { _Pragma("unroll") for (int _i = 0; _i < 2; ++_i) { const unsigned _v = (nx) ? vN[hh][_i] : vC[hh][_i]; \
        __builtin_amdgcn_global_load_lds((const unsigned*)((const char*)(gbase) + _v), (PG8_LAS unsigned*)(lds + (bufoff) + ldsw + _i * 8192), 16, 0, 0); } } \
        else { PG8_STAGE(bufoff, (gbase) + (hh) * hstep, voffA); } } while (0)
#define PG8_LDA(dst, b, h) do { if constexpr (F8) { _Pragma("unroll") for (int m = 0; m < 4; ++m) { const v4i_t lo_ = *(const PG8_LAS v4i_t*)(lds + PG8_SA(b, h) + aoff + m * 2048), hi_ = *(const PG8_LAS v4i_t*)(lds + PG8_SA(b, h) + aoff + m * 2048 + 1024); \
            dst##8[m] = __builtin_shufflevector(lo_, hi_, 0, 1, 2, 3, 4, 5, 6, 7); } } \
        else { _Pragma("unroll") for (int m = 0; m < 4; ++m) _Pragma("unroll") for (int k = 0; k < 2; ++k) dst[m][k] = *(const PG8_LAS bf16x8*)(lds + PG8_SA(b, h) + aoff + m * 2048 + k * 1024); } } while (0)
#define PG8_LDB(dst, b, h) do { if constexpr (F8) { _Pragma("unroll") for (int n = 0; n < 2; ++n) { const v4i_t lo_ = *(const PG8_LAS v4i_t*)(lds + PG8_SB(b, h) + boff + n * 2048), hi_ = *(const PG8_LAS v4i_t*)(lds + PG8_SB(b, h) + boff + n * 2048 + 1024); \
            dst##8[n] = __builtin_shufflevector(lo_, hi_, 0, 1, 2, 3, 4, 5, 6, 7); } } \
        else { _Pragma("unroll") for (int n = 0; n < 2; ++n) _Pragma("unroll") for (int k = 0; k < 2; ++k) dst[n][k] = *(const PG8_LAS bf16x8*)(lds + PG8_SB(b, h) + boff + n * 2048 + k * 1024); } } while (0)
#define PG8_MMA(ai, bj, At, Bt) do { __builtin_amdgcn_s_setprio(1); \
        if constexpr (F8) { _Pragma("unroll") for (int m = 0; m < 4; ++m) _Pragma("unroll") for (int n = 0; n < 2; ++n) \
            asm volatile("v_mfma_scale_f32_16x16x128_f8f6f4 %0, %1, %2, %0, %3, %4 op_sel_hi:[0,0,0]" : "+v"(acc[ai][bj][m][n]) : "v"(Bt##8[n]), "v"(At##8[m]), "v"(sca), "v"(scb)); } \
        else { _Pragma("unroll") for (int m = 0; m < 4; ++m) _Pragma("unroll") for (int n = 0; n < 2; ++n) _Pragma("unroll") for (int k = 0; k < 2; ++k) \
            acc[ai][bj][m][n] = __builtin_amdgcn_mfma_f32_16x16x32_bf16(Bt[n][k], At[m][k], acc[ai][bj][m][n], 0, 0, 0); } \
        __builtin_amdgcn_s_setprio(0); } while (0)
#define PG8_WAIT_V(n) asm volatile("s_waitcnt vmcnt(" #n ")" ::: "memory")
#define PG8_WAIT_L(n) asm volatile("s_waitcnt lgkmcnt(" #n ")" ::: "memory")
#define PG8_BAR __builtin_amdgcn_s_barrier()
#define PG8_SCHED __builtin_amdgcn_sched_barrier(0)
    Unit cur, nxt; int ui = 0;
    if (!S.next(0, cur)) return;
    f32x4 acc[2][2][4][2];
#pragma unroll
    for (int a = 0; a < 2; ++a)
#pragma unroll
        for (int b = 0; b < 2; ++b)
#pragma unroll
            for (int m = 0; m < 4; ++m)
#pragma unroll
                for (int n = 0; n < 2; ++n) acc[a][b][m][n] = (f32x4){0.f, 0.f, 0.f, 0.f};
    const int sca = SA, scb = SB;
    bf16x8 At[4][2], B0[2][2], B1[2][2]; v8i_t At8[4], B08[2], B18[2];
    const char* cA = GATHER ? (const char*)g.A : (const char*)g.A + (size_t)cur.pm * tstep; const char* cB = (const char*)g.Bt + (size_t)cur.e * g.bstride + (size_t)cur.pn * tstep;
    if constexpr (GATHER) { PG8_GOFF(vC, cur); }
    PG8_STAGE(PG8_SB(0, 0), cB, voffB); PG8_STAGE(PG8_SB(0, 1), cB + hstep, voffB); PG8_STAGE_A(PG8_SA(0, 0), cA, 0, false); PG8_STAGE_A(PG8_SA(0, 1), cA, 1, false);
    if (wr == 1) PG8_BAR;
    PG8_WAIT_V(2); PG8_BAR;
    PG8_STAGE(PG8_SB(1, 0), cB + kstep, voffB); PG8_STAGE_A(PG8_SA(1, 0), cA + kstep, 0, false); PG8_STAGE(PG8_SB(1, 1), cB + hstep + kstep, voffB);
    PG8_WAIT_V(6); PG8_BAR;
    for (;;) {
        const bool has_next = S.next(ui + 1, nxt);
        const char* nA = GATHER ? cA : (has_next ? (const char*)g.A + (size_t)nxt.pm * tstep : cA);
        if constexpr (GATHER) { if (has_next) { PG8_GOFF(vN, nxt); } else {
#pragma unroll
            for (int _h = 0; _h < 2; ++_h)
#pragma unroll
                for (int _i = 0; _i < 2; ++_i) vN[_h][_i] = vC[_h][_i]; } }
        const char* nB = has_next ? (const char*)g.Bt + (size_t)nxt.e * g.bstride + (size_t)nxt.pn * tstep : cB;
#if TPROBE == 5
        if (ui > 0) tacc += TP_T() - tp_a;
#endif
#if TPROBE == 2
        tp_a = TP_T();
#endif
#pragma unroll 1
        for (int t = 0; t < nt; t += 2) {
#if TPROBE == 4
            if (t == 0) tp_a = TP_T();
#endif
            const bool last = (t == nt - 2);
            const char* a1 = cA + (size_t)(t + 1) * kstep;
            const char* a2 = last ? nA : cA + (size_t)(t + 2) * kstep; const char* b2 = last ? nB : cB + (size_t)(t + 2) * kstep;
            const char* a3 = a2 + kstep; const char* b3 = b2 + kstep;
            PG8_LDB(B0, 0, 0); PG8_LDB(B1, 0, 1); PG8_SCHED; PG8_LDA(At, 0, 0); PG8_STAGE_A(PG8_SA(1, 1), a1, 1, false);
            PG8_WAIT_V(8); PG8_WAIT_L(0); PG8_BAR; PG8_MMA(0, 0, At, B0); PG8_MMA(0, 1, At, B1); PG8_BAR; PG8_SCHED;
            PG8_LDA(At, 0, 1); PG8_STAGE(PG8_SB(0, 0), b2, voffB); PG8_STAGE(PG8_SB(0, 1), b2 + hstep, voffB); PG8_STAGE_A(PG8_SA(0, 0), a2, 0, last);
            PG8_WAIT_V(8); PG8_WAIT_L(0); PG8_BAR; PG8_MMA(1, 0, At, B0); PG8_MMA(1, 1, At, B1); PG8_BAR; PG8_SCHED;
            PG8_LDB(B0, 1, 0); PG8_LDB(B1, 1, 1); PG8_SCHED; PG8_LDA(At, 1, 0); PG8_STAGE_A(PG8_SA(0, 1), a2, 1, last);
            PG8_WAIT_V(8); PG8_WAIT_L(0); PG8_BAR; PG8_MMA(0, 0, At, B0); PG8_MMA(0, 1, At, B1); PG8_BAR; PG8_SCHED;
            PG8_LDA(At, 1, 1); PG8_STAGE(PG8_SB(1, 0), b3, voffB); PG8_STAGE(PG8_SB(1, 1), b3 + hstep, voffB); PG8_STAGE_A(PG8_SA(1, 0), a3, 0, last);
            PG8_WAIT_V(8); PG8_WAIT_L(0); PG8_BAR; PG8_MMA(1, 0, At, B0); PG8_MMA(1, 1, At, B1); PG8_BAR; PG8_SCHED;
#if TPROBE == 4
            if (t == 0) tacc += TP_T() - tp_a;
#endif
        }
#if TPROBE == 2
        tacc += TP_T() - tp_a;
#endif
#if TPROBE == 1
        tp_a = TP_T();
#endif
        if (wr == 0) PG8_BAR;
        if constexpr (F8) asm volatile("s_nop 15\n\ts_nop 15" ::: "memory");
        E(acc, cur, wr, wc, fr, fq);
#if TPROBE == 1
        tacc += TP_T() - tp_a;
#endif
#if TPROBE == 5
        tp_a = TP_T();
#endif
        if (!has_next) break;
#pragma unroll
        for (int a = 0; a < 2; ++a)
#pragma unroll
            for (int b = 0; b < 2; ++b)
#pragma unroll
                for (int m = 0; m < 4; ++m)
#pragma unroll
                    for (int n = 0; n < 2; ++n) acc[a][b][m][n] = (f32x4){0.f, 0.f, 0.f, 0.f};
        cur = nxt; cA = nA; cB = nB; ++ui;
        if constexpr (GATHER) {
#pragma unroll
            for (int _h = 0; _h < 2; ++_h)
#pragma unroll
                for (int _i = 0; _i < 2; ++_i) vC[_h][_i] = vN[_h][_i]; }
        if (wr == 1) PG8_BAR;
    }
    PG8_WAIT_V(0);
    PG8_BAR;
#if TPROBE == 3
    tacc += TP_T() - tp_entry;
#endif
#undef PG8_SA
#undef PG8_SB
#undef PG8_STAGE
#undef PG8_STAGE_A
#undef PG8_GOFF
#undef PG8_LDA
#undef PG8_LDB
#undef PG8_MMA
#undef PG8_WAIT_V
#undef PG8_WAIT_L
#undef PG8_BAR
#undef PG8_SCHED
}

struct EpiProj {
    static constexpr bool PERM = true;
    bf16_t* O; const f32x2* rope;
    __device__ __forceinline__ void operator()(const f32x4 (&acc)[2][2][4][2], const Unit& u, int wr, int wc, int fr, int fq) const {
        const int row0 = u.pm * BM + wr * 64 + fr, col0 = u.pn * BM + wc * 32 + 8 * fq;
        const int mode = (u.pn < 4) ? 1 : ((u.pn >= 12 && u.pn < 16) ? 2 : 0);
        const float sc = (mode == 1) ? QSCALE : ((u.pn >= 14 && u.pn < 16) ? 0.125f : 1.0f);
#pragma unroll
        for (int ai = 0; ai < 2; ++ai)
#pragma unroll
            for (int m = 0; m < 4; ++m) { const int row = row0 + ai * HALF + m * 16; bf16_t* rowp = O + (size_t)row * NPROJ + col0;
#pragma unroll
                for (int bj = 0; bj < 2; ++bj) { f32x4 v0 = acc[ai][bj][m][0], v1 = acc[ai][bj][m][1];
                    if (mode == 2) { const int t0 = ((col0 + bj * HALF) & 63) >> 1; const f32x4* rp = (const f32x4*)(rope + (size_t)(row & (SEQ - 1)) * 32 + t0);
                        const f32x4 c0 = rp[0], c1 = rp[1];
                        f32x4 w0, w1;
                        w0[0] = v0[0] * c0[0] - v0[1] * c0[1]; w0[1] = v0[0] * c0[1] + v0[1] * c0[0];
                        w0[2] = v0[2] * c0[2] - v0[3] * c0[3]; w0[3] = v0[2] * c0[3] + v0[3] * c0[2];
                        w1[0] = v1[0] * c1[0] - v1[1] * c1[1]; w1[1] = v1[0] * c1[1] + v1[1] * c1[0];
                        w1[2] = v1[2] * c1[2] - v1[3] * c1[3]; w1[3] = v1[2] * c1[3] + v1[3] * c1[2];
                        v0 = w0; v1 = w1; }
                    v0 = v0 * sc; v1 = v1 * sc; v4u w; w.x = cvt_pk_bf16(v0[0], v0[1]); w.y = cvt_pk_bf16(v0[2], v0[3]); w.z = cvt_pk_bf16(v1[0], v1[1]); w.w = cvt_pk_bf16(v1[2], v1[3]);
                    *(v4u*)(rowp + bj * HALF) = w; } }
    }
};
struct EpiRes {
    static constexpr bool PERM = true;
    const bf16_t* xn; const float* irs1; const float* g1; bf16_t* X1; unsigned char* XG; const float* g2;
    __device__ __forceinline__ void operator()(const f32x4 (&acc)[2][2][4][2], const Unit& u, int wr, int wc, int fr, int fq) const {
        const int row0 = u.pm * BM + wr * 64 + fr, col0 = u.pn * BM + wc * 32 + 8 * fq;
        f32x4 ig[2][2];
#pragma unroll
        for (int bj = 0; bj < 2; ++bj)
#pragma unroll
            for (int n = 0; n < 2; ++n) { const f32x4 t = *(const f32x4*)(g1 + col0 + bj * HALF + 4 * n); ig[bj][n] = (f32x4){1.0f / t[0], 1.0f / t[1], 1.0f / t[2], 1.0f / t[3]}; }
#pragma unroll
        for (int ai = 0; ai < 2; ++ai) {
            v4u xb[4][2]; float ir[4];
#pragma unroll
            for (int m = 0; m < 4; ++m) { ir[m] = irs1[row0 + ai * HALF + m * 16];
#pragma unroll
                for (int bj = 0; bj < 2; ++bj) xb[m][bj] = *(const v4u*)(xn + (size_t)(row0 + ai * HALF + m * 16) * DM + col0 + bj * HALF); }
#pragma unroll
            for (int m = 0; m < 4; ++m) { const size_t off = (size_t)(row0 + ai * HALF + m * 16) * DM + col0;
#pragma unroll
                for (int bj = 0; bj < 2; ++bj) { const v4u xw = xb[m][bj]; const float rr = ir[m];
                    const f32x4 x0 = (f32x4){bf2f(xw.x & 0xffff), bf2f(xw.x >> 16), bf2f(xw.y & 0xffff), bf2f(xw.y >> 16)} * ig[bj][0] * rr, x1 = (f32x4){bf2f(xw.z & 0xffff), bf2f(xw.z >> 16), bf2f(xw.w & 0xffff), bf2f(xw.w >> 16)} * ig[bj][1] * rr;
                    const f32x4 v0 = x0 + acc[ai][bj][m][0], v1 = x1 + acc[ai][bj][m][1];
                    v4u w; w.x = cvt_pk_bf16(v0[0], v0[1]); w.y = cvt_pk_bf16(v0[2], v0[3]); w.z = cvt_pk_bf16(v1[0], v1[1]); w.w = cvt_pk_bf16(v1[2], v1[3]);
                    *(v4u*)(X1 + off + bj * HALF) = w;
                } } }
    }
};
struct EpiSwiglu {
    static constexpr bool PERM = true;
    unsigned char* O; const float* lst_rs;
    __device__ __forceinline__ void operator()(const f32x4 (&acc)[2][2][4][2], const Unit& u, int wr, int wc, int fr, int fq) const {
        const int row0 = u.pm * BM + wr * 64 + fr, f0 = u.pn * 128 + wc * 16 + 4 * fq;
#pragma unroll
        for (int ai = 0; ai < 2; ++ai)
#pragma unroll
            for (int m = 0; m < 4; ++m) { const int row = row0 + ai * HALF + m * 16; const float rs = lst_rs[u.e * LCAP + u.rl0 + (row - u.pm * BM)]; unsigned char* rowp = O + (size_t)row * FF + f0;
#pragma unroll
                for (int bj = 0; bj < 2; ++bj) { const f32x4 a = acc[ai][bj][m][0] * rs, b = acc[ai][bj][m][1] * rs; f32x4 r;
#pragma unroll
                    for (int j = 0; j < 4; ++j) r[j] = a[j] * __builtin_amdgcn_rcpf(1.0f + __builtin_amdgcn_exp2f(-a[j] * LOG2E)) * b[j];
                    *(unsigned*)(rowp + bj * 64) = pk4_fp8(r[0], r[1], r[2], r[3]); } }
    }
};
struct EpiDown {
    static constexpr bool PERM = true;
    unsigned char* O; const float* lst_gate;
    __device__ __forceinline__ void operator()(const f32x4 (&acc)[2][2][4][2], const Unit& u, int wr, int wc, int fr, int fq) const {
        const int row0 = u.pm * BM + wr * 64 + fr, col0 = u.pn * BM + wc * 32 + 8 * fq;
#pragma unroll
        for (int ai = 0; ai < 2; ++ai)
#pragma unroll
            for (int m = 0; m < 4; ++m) { const int row = row0 + ai * HALF + m * 16; const float gt = lst_gate[u.e * LCAP + u.rl0 + (row - u.pm * BM)] * YSCALE; unsigned char* rowp = O + (size_t)row * DM + col0;
#pragma unroll
                for (int bj = 0; bj < 2; ++bj) { const f32x4 v0 = acc[ai][bj][m][0] * gt, v1 = acc[ai][bj][m][1] * gt;
                    v2u w; w.x = pk4_fp8(v0[0], v0[1], v0[2], v0[3]); w.y = pk4_fp8(v1[0], v1[1], v1[2], v1[3]);
                    *(v2u*)(rowp + bj * HALF) = w; } }
    }
};
}

namespace att {
constexpr int KOFF0 = 0, KOFF1 = 8192, VOFF = 16384, BUFB = 32768;
constexpr int TBOFF = 65536, WSFOFF = 66816, QFOFF0 = 69632, QFOFF1 = 98304;
constexpr int STG_PITCH = 132, STG_WAVE = 32 * STG_PITCH * 4;
constexpr float THR = 8.0f;
__device__ __forceinline__ int crow(int r, int hi) { return (r & 3) + 8 * (r >> 2) + 4 * hi; }
__device__ __forceinline__ s16x4 vtr(const LAS unsigned char* p) { typedef short v4i16_t __attribute__((ext_vector_type(4))); return __builtin_bit_cast(s16x4, __builtin_amdgcn_ds_read_tr16_b64_v4i16((LAS v4i16_t*)p)); }

struct Args { const bf16* proj; bf16* mix; const float* tb; const float* subln_g; const float* gn_g; float lam; };

#define ATT_SRC(L) unsigned ksrc, vsrc; \
    { const int row_ = 8 * wid + ((L) >> 3), slot_ = (L) & 7, ch_ = slot_ ^ ((row_ >> 1) & 7); ksrc = (unsigned)(row_ * NPROJ + ck + ch_ * 8) * 2u; } \
    { const int row_ = 8 * wid + ((L) >> 4), slot_ = (L) & 15; vsrc = (unsigned)(row_ * NPROJ + cv + ((slot_ ^ ((row_ & 3) << 2)) * 8)) * 2u; }
#define ATT_STAGE(t, bufo) do { const char* _b = pbase + (size_t)(t) * 64 * NPROJ * 2; \
        __builtin_amdgcn_global_load_lds((const unsigned*)(_b + ksrc), (LAS unsigned*)(lds + (bufo) + KOFF0 + ldsw), 16, 0, 0); \
        if (MODE == 0) __builtin_amdgcn_global_load_lds((const unsigned*)(_b + ksrc + 128), (LAS unsigned*)(lds + (bufo) + KOFF1 + ldsw), 16, 0, 0); \
        __builtin_amdgcn_global_load_lds((const unsigned*)(_b + vsrc), (LAS unsigned*)(lds + (bufo) + VOFF + 2 * ldsw), 16, 0, 0); \
        __builtin_amdgcn_global_load_lds((const unsigned*)(_b + vsrc + 4 * NPROJ * 2), (LAS unsigned*)(lds + (bufo) + VOFF + 2 * ldsw + 1024), 16, 0, 0); } while (0)

constexpr float WSCALE = 32.0f;
struct Bg { const float* wg; const float* wu; const float* wd; unsigned char* btgu; unsigned char* btd; int it, end; bool have; f32x4 r[8]; };
__device__ __forceinline__ void bg_decode(const Bg& B, int it, int lane, const float*& src, int& N, unsigned char*& dst, int& K) {
    const int me = it >> 10, r = it & 1023, e = me / 3, w = me - 3 * e, n4 = lane & 7, kr = lane >> 3;
    if (w == 2) { N = DM; K = FF; const int kb = r >> 6, nb = r & 63, nn = 32 * nb + 4 * n4, k0 = 64 * kb + 8 * kr; src = B.wd + (size_t)e * FF * DM + (size_t)k0 * DM + nn; dst = B.btd + (size_t)e * DM * FF + (size_t)nn * FF + k0; }
    else { N = FF; K = DM; const int kb = r >> 5, nb = r & 31, nn = 32 * nb + 4 * n4, k0 = 64 * kb + 8 * kr; src = (w == 0 ? B.wg : B.wu) + (size_t)e * DM * FF + (size_t)k0 * FF + nn;
           dst = B.btgu + (size_t)e * 2048 * DM + (size_t)(8 * (nn >> 2) + 4 * w) * DM + k0; }
}
__device__ __forceinline__ void bg_issue(Bg& B, int lane) {
    if (BG_MODE != 0 && B.it < B.end) { const float* src; unsigned char* dst; int N, K; bg_decode(B, B.it, lane, src, N, dst, K);
#pragma unroll
        for (int j = 0; j < 8; ++j) B.r[j] = __builtin_nontemporal_load((const f32x4*)(src + (size_t)j * N));
        B.have = true; ++B.it; }
}
__device__ __forceinline__ void bg_retire(Bg& B, int lane) {
    if (B.have) { const float* src; unsigned char* dst; int N, K; bg_decode(B, B.it - 1, lane, src, N, dst, K);
#pragma unroll
        for (int i = 0; i < 4; ++i) { v2u w; w.x = pk4_fp8(B.r[0][i] * WSCALE, B.r[1][i] * WSCALE, B.r[2][i] * WSCALE, B.r[3][i] * WSCALE); w.y = pk4_fp8(B.r[4][i] * WSCALE, B.r[5][i] * WSCALE, B.r[6][i] * WSCALE, B.r[7][i] * WSCALE);
            *(v2u*)(dst + (size_t)i * K) = w; }
        B.have = false; }
}

template <int MODE>
__device__ __forceinline__ void attn_unit(const Args& A, Bg& BG, int b, int h, int qb, LAS unsigned char* lds) {
    constexpr int NMAP = (MODE == 0) ? 2 : 1, NBUF = (MODE == 0) ? 2 : 3, QFOFF = (MODE == 0) ? QFOFF0 : QFOFF1, NGL = (MODE == 0) ? 4 : 3;
    int tid = threadIdx.x; asm volatile("" : "+v"(tid));
    const int lane = tid & 63, wid = __builtin_amdgcn_readfirstlane(tid >> 6);
    const int q0 = qb * 256, qw = q0 + wid * 32;
    const size_t rowbase = (size_t)b * SEQ;
    const int cq = (MODE == 0) ? C_DQ + h * 128 : C_RQ + h * 64;
    const int ck = (MODE == 0) ? C_DK + h * 128 : C_RK + h * 64;
    const int cv = (MODE == 0) ? C_DV + h * 128 : C_RV + h * 128;
    const int NT = (q0 + 256) / 64;
    const int ntw = (qw + 31) / 64 + 1;
    const char* pbase = (const char*)(A.proj + rowbase * NPROJ);
    const unsigned ldsw = (unsigned)wid * 1024u;
    LAS float* tbl = (LAS float*)(lds + TBOFF);
    { ATT_SRC(lane); ATT_STAGE(0, 0); if (NBUF == 3 && NT > 1) ATT_STAGE(1, BUFB); }
    if (MODE == 0) { if (tid < 304) tbl[tid] = A.tb[h * 304 + tid]; }
    { LAS unsigned char* qw_ = lds + QFOFF + wid * (NMAP * 4096) + lane * 16; const char* qg = pbase + (size_t)((qw + (lane & 31)) * NPROJ + cq + (lane >> 5) * 8) * 2;
#pragma unroll
      for (int f = 0; f < NMAP * 4; ++f) *(LAS v4u*)(qw_ + f * 1024) = *(const v4u*)(qg + (f >> 2) * 128 + (f & 3) * 32); }
    f32x16 o[NMAP][4];
#pragma unroll
    for (int c = 0; c < NMAP; ++c)
#pragma unroll
        for (int d = 0; d < 4; ++d)
#pragma unroll
            for (int r = 0; r < 16; ++r) o[c][d][r] = 0.f;
    float mref[NMAP], lsum[NMAP];
#pragma unroll
    for (int c = 0; c < NMAP; ++c) { mref[c] = -INFINITY; lsum[c] = 0.f; }
    float cg = 0.f;
    if (MODE == 1) { const double x = __builtin_ldexp(1.0, -5 - h); const double s = x * (1.0 + x * (0.5 + x * (1.0 / 3 + x * (0.25 + x * (0.2 + x * (1.0 / 6 + x * (1.0 / 7)))))));
        cg = (float)(-s * 1.4426950408889634); }
    VM_WAIT(); __syncthreads();
    for (int t = 0; t < NT; ++t) {
        const int bufo = (NBUF == 2 ? (t & 1) : (t % 3)) * BUFB, t0 = t * 64;
        int ln = lane; asm volatile("" : "+v"(ln));
        const bool staged = (t + NBUF - 1 < NT);
        if (staged) { ATT_SRC(ln); ATT_STAGE(t + NBUF - 1, ((t + NBUF - 1) % NBUF) * BUFB); }
        bool bg_now = false;
#define ATT_BGMID() do { bg_retire(BG, ln); const int ib_ = BG.it; if (MODE == 0 || (t % 3) == 0) bg_issue(BG, ln); bg_now = BG.it != ib_; } while (0)
        if (t >= ntw) ATT_BGMID();
        if (t < ntw) {
            const int r32 = ln & 31, hi = ln >> 5;
            const LAS unsigned char* kb = lds + bufo; const LAS unsigned char* vb = lds + bufo + VOFF;
            const bool near = (qw - t0) <= 175, diag = (t0 + 63) > qw;
            const int kbase = r32 * 128 + ((((r32 >> 2) & 3)) << 5) + ((hi ^ ((r32 >> 1) & 1)) << 4);
            int vbase;
            { const int i16 = ln & 15, q = i16 >> 2, p = i16 & 3, g = (ln >> 4) & 1; vbase = (4 * hi + q) * 256 + (((q << 2) + 2 * g + (p >> 1)) << 4) + 8 * (p & 1); }
            const LAS unsigned char* qlds = lds + QFOFF + wid * (NMAP * 4096) + ln * 16;
            LAS float* wsf = (LAS float*)(lds + WSFOFF) + wid * 64;
#pragma unroll
            for (int kh = 0; kh < 2; ++kh) {
              if (kh == 1) ATT_BGMID();
              if (t0 + 32 * kh > qw + 31) continue;
#pragma unroll
              for (int c = 0; c < NMAP; ++c) {
                f32x16 p;
                __builtin_amdgcn_sched_barrier(0);
                if (MODE == 0 && near) { const LAS float* tp = tbl + (207 - (qw + r32 - t0) + 4 * hi + 32 * kh);
#pragma unroll
                    for (int r = 0; r < 16; ++r) p[r] = tp[(r & 3) + 8 * (r >> 2)];
                } else { const float ini = (MODE == 0) ? tbl[0] : 0.f;
#pragma unroll
                    for (int r = 0; r < 16; ++r) p[r] = ini; }
#pragma unroll
                for (int s = 0; s < 4; ++s) {
                    const bf16x8 qf = *(const LAS bf16x8*)(qlds + (c * 4 + s) * 1024);
                    const bf16x8 kf = *(const LAS bf16x8*)(kb + c * KOFF1 + (kbase ^ (s << 5)) + kh * 4096);
                    p = __builtin_amdgcn_mfma_f32_32x32x16_bf16(kf, qf, p, 0, 0, 0);
                }
                const int qrel = qw + r32 - t0 - 4 * hi - 32 * kh;
                if (MODE == 0) {
                    if (diag) {
#pragma unroll
                        for (int r = 0; r < 16; ++r) { if ((r & 3) + 8 * (r >> 2) > qrel) p[r] = -INFINITY; } }
                    float rm = fmaxf(p[0], p[1]);
#pragma unroll
                    for (int r = 2; r < 16; ++r) rm = fmaxf(rm, p[r]);
                    { auto rr = __builtin_amdgcn_permlane32_swap(__float_as_uint(rm), __float_as_uint(rm), false, false); rm = fmaxf(__uint_as_float(rr[0]), __uint_as_float(rr[1])); }
                    if (__any(rm > mref[c] + THR)) {
                        const float mn = fmaxf(mref[c], rm); const float al = __builtin_amdgcn_exp2f(mref[c] - mn);
                        lsum[c] *= al; mref[c] = mn;
                        if (hi == 0) wsf[r32] = al;
                        LDS_WAIT();
#pragma unroll
                        for (int r = 0; r < 16; ++r) { const float a = wsf[crow(r, hi)];
#pragma unroll
                            for (int d = 0; d < 4; ++d) o[c][d][r] *= a; }
                        LDS_WAIT();
                    }
                    const float mm = mref[c]; float sacc = 0.f;
#pragma unroll
                    for (int r = 0; r < 16; ++r) { p[r] = __builtin_amdgcn_exp2f(p[r] - mm); sacc += p[r]; }
                    lsum[c] += sacc;
                } else {
                    const float rf = __builtin_amdgcn_exp2f(cg * (float)(qw + r32 - t0 - 32 * kh));
#pragma unroll
                    for (int r = 0; r < 16; ++r) { const float cf = __builtin_amdgcn_exp2f(-cg * (float)crow(r, hi)); p[r] = p[r] * (cf * rf); }
                    if (diag) {
#pragma unroll
                        for (int r = 0; r < 16; ++r) { if ((r & 3) + 8 * (r >> 2) > qrel) p[r] = 0.f; } }
                }
                v4u pa[2];
                pa[0] = (v4u){cvt_pk_bf16(p[0], p[1]), cvt_pk_bf16(p[2], p[3]), cvt_pk_bf16(p[4], p[5]), cvt_pk_bf16(p[6], p[7])};
                pa[1] = (v4u){cvt_pk_bf16(p[8], p[9]), cvt_pk_bf16(p[10], p[11]), cvt_pk_bf16(p[12], p[13]), cvt_pk_bf16(p[14], p[15])};
                { s16x4 va[4], vbq[4];
                  const int vad0 = (int)(uintptr_t)vb + (vbase ^ (0 << 6)) + kh * 8192, vad1 = (int)(uintptr_t)vb + (vbase ^ (1 << 6)) + kh * 8192;
                  const int vad2 = (int)(uintptr_t)vb + (vbase ^ (2 << 6)) + kh * 8192, vad3 = (int)(uintptr_t)vb + (vbase ^ (3 << 6)) + kh * 8192;
#define ATT_VRD(dst, ad) do { asm volatile("ds_read_b64_tr_b16 %0, %1" : "=v"(dst[0]) : "v"(ad) : "memory"); asm volatile("ds_read_b64_tr_b16 %0, %1 offset:2048" : "=v"(dst[1]) : "v"(ad) : "memory"); \
                                   asm volatile("ds_read_b64_tr_b16 %0, %1 offset:4096" : "=v"(dst[2]) : "v"(ad) : "memory"); asm volatile("ds_read_b64_tr_b16 %0, %1 offset:6144" : "=v"(dst[3]) : "v"(ad) : "memory"); } while (0)
#define ATT_VWAIT() do { asm volatile("s_waitcnt lgkmcnt(0)" ::: "memory"); __builtin_amdgcn_sched_barrier(0); } while (0)
#define ATT_PV(d, vv) do { o[c][d] = __builtin_amdgcn_mfma_f32_32x32x16_bf16(__builtin_bit_cast(bf16x8, pa[0]), ((bf16x8){vv[0][0], vv[0][1], vv[0][2], vv[0][3], vv[1][0], vv[1][1], vv[1][2], vv[1][3]}), o[c][d], 0, 0, 0); \
                                o[c][d] = __builtin_amdgcn_mfma_f32_32x32x16_bf16(__builtin_bit_cast(bf16x8, pa[1]), ((bf16x8){vv[2][0], vv[2][1], vv[2][2], vv[2][3], vv[3][0], vv[3][1], vv[3][2], vv[3][3]}), o[c][d], 0, 0, 0); } while (0)
                  __builtin_amdgcn_sched_barrier(0);
                  ATT_VRD(va, vad0); ATT_VWAIT();
                  ATT_VRD(vbq, vad1); __builtin_amdgcn_sched_barrier(0); ATT_PV(0, va); __builtin_amdgcn_sched_barrier(0); ATT_VWAIT();
                  ATT_VRD(va, vad2); __builtin_amdgcn_sched_barrier(0); ATT_PV(1, vbq); __builtin_amdgcn_sched_barrier(0); ATT_VWAIT();
                  ATT_VRD(vbq, vad3); __builtin_amdgcn_sched_barrier(0); ATT_PV(2, va); __builtin_amdgcn_sched_barrier(0); ATT_VWAIT();
                  ATT_PV(3, vbq); __builtin_amdgcn_sched_barrier(0);
#undef ATT_VRD
#undef ATT_VWAIT
#undef ATT_PV
                }
              }
            }
        }
        if (NBUF == 3 && staged) { if (bg_now) asm volatile("s_waitcnt vmcnt(11)" ::: "memory"); else asm volatile("s_waitcnt vmcnt(3)" ::: "memory"); }
        else { if (bg_now) asm volatile("s_waitcnt vmcnt(8)" ::: "memory"); else VM_WAIT(); }
#undef ATT_BGMID
        __syncthreads();
    }
    int lane_e = lane; asm volatile("" : "+v"(lane_e));
    LAS float* stg = (LAS float*)(lds + wid * STG_WAVE);
    { const int r32 = lane_e & 31, hi = lane_e >> 5;
      if (MODE == 0) {
        LAS float* wsf2 = (LAS float*)(lds + 8 * STG_WAVE) + wid * 64;
        float l0 = lsum[0], l1 = lsum[NMAP - 1];
        { auto rr = __builtin_amdgcn_permlane32_swap(__float_as_uint(l0), __float_as_uint(l0), false, false); l0 = __uint_as_float(rr[0]) + __uint_as_float(rr[1]); }
        { auto rr = __builtin_amdgcn_permlane32_swap(__float_as_uint(l1), __float_as_uint(l1), false, false); l1 = __uint_as_float(rr[0]) + __uint_as_float(rr[1]); }
        if (hi == 0) { wsf2[r32] = 1.0f / l0; wsf2[32 + r32] = -A.lam / l1; }
        LDS_WAIT();
#pragma unroll
        for (int r = 0; r < 16; ++r) { const float a0 = wsf2[crow(r, hi)], a1 = wsf2[32 + crow(r, hi)];
#pragma unroll
            for (int d = 0; d < 4; ++d) stg[crow(r, hi) * STG_PITCH + d * 32 + r32] = o[0][d][r] * a0 + o[NMAP - 1][d][r] * a1; }
      } else {
#pragma unroll
        for (int r = 0; r < 16; ++r)
#pragma unroll
            for (int d = 0; d < 4; ++d) stg[crow(r, hi) * STG_PITCH + d * 32 + r32] = o[0][d][r];
      }
    }
    LDS_WAIT();
    const int c8 = lane_e & 15;
#pragma unroll
    for (int ps = 0; ps < 8; ++ps) {
        const int row = 4 * ps + (lane_e >> 4);
        const f32x4 va = *(const LAS f32x4*)(stg + row * STG_PITCH + 8 * c8), vb4 = *(const LAS f32x4*)(stg + row * STG_PITCH + 8 * c8 + 4);
        float v[8] = {va[0], va[1], va[2], va[3], vb4[0], vb4[1], vb4[2], vb4[3]};
        const size_t tok = rowbase + qw + row;
        float ov[8];
        if (MODE == 0) {
            float ss = 0.f;
#pragma unroll
            for (int j = 0; j < 8; ++j) ss += v[j] * v[j];
            ss += __shfl_xor(ss, 1); ss += __shfl_xor(ss, 2); ss += __shfl_xor(ss, 4); ss += __shfl_xor(ss, 8);
            const float rn = 0.8f / sqrtf(ss * (1.0f / 128.0f) + EPS);
            const f32x4 g0 = *(const f32x4*)(A.subln_g + 8 * c8), g1 = *(const f32x4*)(A.subln_g + 8 * c8 + 4);
#pragma unroll
            for (int j = 0; j < 4; ++j) { ov[j] = v[j] * rn * g0[j]; ov[4 + j] = v[4 + j] * rn * g1[j]; }
        } else {
            float s1 = 0.f;
#pragma unroll
            for (int j = 0; j < 8; ++j) s1 += v[j];
            s1 += __shfl_xor(s1, 1); s1 += __shfl_xor(s1, 2); s1 += __shfl_xor(s1, 4); s1 += __shfl_xor(s1, 8);
            const float mu = s1 * (1.0f / 128.0f); float s2 = 0.f;
#pragma unroll
            for (int j = 0; j < 8; ++j) { v[j] -= mu; s2 += v[j] * v[j]; }
            s2 += __shfl_xor(s2, 1); s2 += __shfl_xor(s2, 2); s2 += __shfl_xor(s2, 4); s2 += __shfl_xor(s2, 8);
            const float rn = 1.0f / sqrtf(s2 * (1.0f / 128.0f) + EPS);
            const f32x4 g0 = *(const f32x4*)(A.gn_g + h * 128 + 8 * c8), g1 = *(const f32x4*)(A.gn_g + h * 128 + 8 * c8 + 4);
            const v4u gw = *(const v4u*)(A.proj + tok * NPROJ + C_RG + h * 128 + 8 * c8);
            float gt[8] = {bf2f(gw.x & 0xffff), bf2f(gw.x >> 16), bf2f(gw.y & 0xffff), bf2f(gw.y >> 16), bf2f(gw.z & 0xffff), bf2f(gw.z >> 16), bf2f(gw.w & 0xffff), bf2f(gw.w >> 16)};
#pragma unroll
            for (int j = 0; j < 8; ++j) { const float gg = (j < 4) ? g0[j] : g1[j - 4]; const float sl = gt[j] * __builtin_amdgcn_rcpf(1.0f + __builtin_amdgcn_exp2f(-gt[j] * LOG2E)); ov[j] = sl * (v[j] * rn * gg); }
        }
        v4u w; w.x = cvt_pk_bf16(ov[0], ov[1]); w.y = cvt_pk_bf16(ov[2], ov[3]); w.z = cvt_pk_bf16(ov[4], ov[5]); w.w = cvt_pk_bf16(ov[6], ov[7]);
        *(v4u*)(A.mix + tok * DM + (MODE == 0 ? 0 : 1024) + h * 128 + 8 * c8) = w;
    }
    LDS_WAIT(); __syncthreads();
}
#undef ATT_STAGE
#undef ATT_SRC
}

#define XB_TMO      128
#define XB_XCNT(j)  (256  + 64 * (j))
#define XB_XSUB(j)  (1280 + 64 * (j))
#define XB_XGEN(j)  (2304 + 64 * (j))
#define XB_TOP      3328
#define XB_TOPGEN   3392
#define XCD_BAR_WORDS 3456
#define XB_SPIN_CAP (1u << 18)
__device__ __forceinline__ unsigned xb_ld(unsigned* p)              { return __hip_atomic_load(p, __ATOMIC_RELAXED, __HIP_MEMORY_SCOPE_AGENT); }
__device__ __forceinline__ unsigned xb_add(unsigned* p, unsigned v) { return __hip_atomic_fetch_add(p, v, __ATOMIC_RELAXED, __HIP_MEMORY_SCOPE_AGENT); }
__device__ __forceinline__ unsigned xb_xcc_id() { return (unsigned)__builtin_amdgcn_s_getreg((3 << 11) | 20) & 0xFu; }
#define XB_SPIN(cond, bar) do { unsigned _sp = 0; while (cond) { __builtin_amdgcn_s_sleep(1); \
    if ((++_sp & 255u) == 0u) { if (xb_ld(&(bar)[XB_TMO])) break; if (_sp > XB_SPIN_CAP) { atomicAdd(&(bar)[XB_TMO], 1u); break; } } } } while (0)
struct XcdBarrier { unsigned* bar; unsigned x; volatile LAS unsigned* st; };
__device__ __forceinline__ XcdBarrier xcd_barrier_post(unsigned* bar, volatile LAS unsigned* st) {
    XcdBarrier b; b.bar = bar; b.x = xb_xcc_id(); b.st = st;
    if (threadIdx.x == 0) (void)xb_add(&bar[XB_XCNT(b.x)], 1u);
    return b;
}
__device__ __forceinline__ void xcd_barrier_complete(unsigned* bar, unsigned x, unsigned& nloc, unsigned& nx) {
    const unsigned G = gridDim.x * gridDim.y * gridDim.z;
    unsigned sum, cnt, mine, sp = 0u;
    for (;;) {
        sum = 0u; cnt = 0u; mine = 0u;
#pragma unroll
        for (unsigned j = 0; j < 16; ++j) { const unsigned c = xb_ld(&bar[XB_XCNT(j)]); sum += c; cnt += (c > 0u) ? 1u : 0u; mine = (j == x) ? c : mine; }
        if (sum == G) break;
        __builtin_amdgcn_s_sleep(1);
        if ((++sp & 255u) == 0u) { if (xb_ld(&bar[XB_TMO])) break; if (sp > XB_SPIN_CAP) { atomicAdd(&bar[XB_TMO], 1u); break; } }
    }
    nloc = mine > 0u ? mine : 1u; nx = cnt > 0u ? cnt : 1u;
}
__device__ __forceinline__ void xcd_barrier(const XcdBarrier& b) {
    asm volatile("s_waitcnt vmcnt(0)" ::: "memory");
    __syncthreads();
    if (threadIdx.x == 0) {
        unsigned* bar = b.bar;
        __builtin_amdgcn_s_waitcnt(0);
        unsigned nloc = b.st[0], nx = b.st[1];
        if (nloc == 0u) { xcd_barrier_complete(bar, b.x, nloc, nx); b.st[0] = nloc; b.st[1] = nx; }
        const unsigned old = xb_add(&bar[XB_XSUB(b.x)], 1u);
        const unsigned gen = old / nloc;
        if (old + 1u == (gen + 1u) * nloc) {
            __builtin_amdgcn_fence(__ATOMIC_RELEASE, "agent");
            asm volatile("s_waitcnt vmcnt(0)" ::: "memory");
            const unsigned og = xb_add(&bar[XB_TOP], 1u);
            const unsigned tg = og / nx;
            if (og + 1u == (tg + 1u) * nx) xb_add(&bar[XB_TOPGEN], 1u);
            else XB_SPIN(xb_ld(&bar[XB_TOPGEN]) == tg, bar);
            __builtin_amdgcn_fence(__ATOMIC_ACQUIRE, "agent");
            xb_add(&bar[XB_XGEN(b.x)], 1u);
            asm volatile("s_waitcnt vmcnt(0)" ::: "memory");
        } else {
            XB_SPIN(xb_ld(&bar[XB_XGEN(b.x)]) == gen, bar);
            __builtin_amdgcn_fence(__ATOMIC_ACQUIRE, "agent");
            asm volatile("s_waitcnt vmcnt(0)" ::: "memory");
        }
    }
    __syncthreads();
}

template <int MODE>
__device__ __forceinline__ int dest_row(int n) {
    if (MODE == 1) { if (n >= C_RQ && n < C_RV) { const int i = n & 63; return (n & ~63) + 2 * (i & 31) + (i >> 5); } return n; }
    if (MODE == 2) return 8 * (n >> 2) + (n & 3);
    if (MODE == 3) return 8 * (n >> 2) + 4 + (n & 3);
    return n;
}
template <int MODE>
__device__ __forceinline__ void p0_transpose_item(const float* W, int K, int N, bf16* WT, LAS float* scr, int item, int lane) {
    const int nblk = N / 32, kb = item / nblk, nb = item % nblk, k0 = 64 * kb, n0 = 32 * nb;
    float wv[32];
#pragma unroll
    for (int i = 0; i < 32; ++i) { const int kk = 2 * i + (lane >> 5); wv[i] = W[(size_t)(k0 + kk) * N + n0 + (lane & 31)]; }
#pragma unroll
    for (int i = 0; i < 32; ++i) { const int kk = 2 * i + (lane >> 5); scr[kk * 33 + (lane & 31)] = wv[i]; }
    LDS_WAIT(); asm volatile("" ::: "memory");
    const int c = lane & 7;
#pragma unroll
    for (int j = 0; j < 4; ++j) { const int n = (lane >> 3) + 8 * j; const LAS float* s = scr + (8 * c) * 33 + n;
        v4u o; o.x = pk2(s[0 * 33], s[1 * 33]); o.y = pk2(s[2 * 33], s[3 * 33]); o.z = pk2(s[4 * 33], s[5 * 33]); o.w = pk2(s[6 * 33], s[7 * 33]);
        *(GAS v4u*)(WT + (size_t)dest_row<MODE>(n0 + n) * K + k0 + 8 * c) = o; }
    LDS_WAIT(); asm volatile("" ::: "memory");
}

template <int MODE>
__device__ __forceinline__ void p0_direct_item(const float* W, int K, int N, bf16* WT, int item, int lane) {
    const int nblk = N / 32, kb = item / nblk, nb = item % nblk, n4 = lane & 7, kr = lane >> 3, k0 = 64 * kb + 8 * kr, n0 = 32 * nb + 4 * n4;
    const float* src = W + (size_t)k0 * N + n0;
    f32x4 r[8];
#pragma unroll
    for (int j = 0; j < 8; ++j) r[j] = *(const f32x4*)(src + (size_t)j * N);
#pragma unroll
    for (int i = 0; i < 4; ++i) { v4u w; w.x = pk2(r[0][i], r[1][i]); w.y = pk2(r[2][i], r[3][i]); w.z = pk2(r[4][i], r[5][i]); w.w = pk2(r[6][i], r[7][i]);
        *(GAS v4u*)(WT + (size_t)dest_row<MODE>(n0 + i) * K + k0) = w; }
}

struct KArgs { const float* in[20]; float* out; unsigned char* ws; int ph_lo, ph_hi; };

__global__ void __launch_bounds__(512, 2) hymba_fwd(KArgs args) {
    extern __shared__ __attribute__((aligned(16))) unsigned char lds_raw[];
    LAS unsigned char* lds = (LAS unsigned char*)lds_raw;
    volatile LAS unsigned* MISC = (volatile LAS unsigned*)(lds + MISC_OFF);
    LAS int* LTAB = (LAS int*)(lds + LTAB_OFF);
    const int tid = threadIdx.x, lane = tid & 63, wave = __builtin_amdgcn_readfirstlane(tid >> 6);
    const int G = gridDim.x; const int vcu = (G % 8 == 0) ? ((int)blockIdx.x % 8) * (G / 8) + (int)blockIdx.x / 8 : (int)blockIdx.x;
    const int gw = vcu * 8 + wave, NGW = G * 8;
    unsigned char* ws = args.ws;
    gu32* ctl = (gu32*)(ws + WS_CTL);
    const float* x = args.in[0]; const float* rel_bias = args.in[1]; const float* attn_norm_g = args.in[2]; const float* w_in = args.in[3];
    const float* lq1 = args.in[4]; const float* lk1 = args.in[5]; const float* lq2 = args.in[6]; const float* lk2 = args.in[7];
    const float* subln_g = args.in[8]; const float* gn_g = args.in[9]; const float* w_out = args.in[10]; const float* ffn_norm_g = args.in[11];
    const float* w_gr = args.in[12]; const float* b_group = args.in[13]; const float* w_ir = args.in[14]; const float* b_inner = args.in[15];
    const float* w_gate = args.in[16]; const float* w_up = args.in[17]; const float* w_down = args.in[18]; const float* final_g = args.in[19];
    float* out = args.out;
    f32x2* rope = (f32x2*)(ws + WS_ROPE); float* tbw = (float*)(ws + WS_TB);
    bf16* WRH = (bf16*)(ws + WS_WRH); bf16* WRL = (bf16*)(ws + WS_WRL);
    int* tok_e = (int*)(ws + WS_TOK + TOK_E); int* tok_rank = (int*)(ws + WS_TOK + TOK_RANK); float* irs1 = (float*)(ws + WS_TOK + TOK_GATE);
    float* tok_rs2 = (float*)(ws + WS_TOK + TOK_RS2); int* tok_pos = (int*)(ws + WS_TOK + TOK_POS); float* row_gate = (float*)(ws + WS_TOK + ROW_GATE);
    int* lst_tok = (int*)(ws + WS_LST); float* lst_rs = (float*)(ws + WS_LST + 2 * MiB); float* lst_gate = (float*)(ws + WS_LST + 4 * MiB);
    bf16* BTIN = (bf16*)(ws + WS_BTIN); bf16* BTOUT = (bf16*)(ws + WS_BTOUT); unsigned char* BTGU = ws + WS_BTGU; unsigned char* BTD = ws + WS_BTD;
    bf16* XN = (bf16*)(ws + WS_XN); bf16* MIX = (bf16*)(ws + WS_MIX); unsigned char* ACT = ws + WS_ACT;
    bf16* PROJ = (bf16*)(ws + WS_PROJ); unsigned char* XG = ws + WS_XG; unsigned char* Y = ws + WS_Y;
    bf16* X1 = (bf16*)(ws + WS_X1);

    for (int u = tid; u < (LDS_BYTES - LDSCTL_OFF) / 4; u += 512) ((LAS unsigned*)(lds + LDSCTL_OFF))[u] = 0u;
    __syncthreads();
    XcdBarrier bar; bar.bar = (unsigned*)(ctl + CW_BAR); bar.x = 0; bar.st = nullptr;
    if (N_LAUNCHES == 1) bar = xcd_barrier_post((unsigned*)(ctl + CW_BAR), MISC + 8);
    const int lo = args.ph_lo, hi_ph = args.ph_hi;
    long long tacc = 0, tdum = 0;
#if TPROBE == 7 || TPROBE == 9
    long long tprev = TP_T();
#endif
#if TPROBE == 10
    if (tid == 0) { const unsigned ts_ = (unsigned)__builtin_amdgcn_s_memrealtime(); __hip_atomic_fetch_max((unsigned*)(ctl + 32768), ts_, RLX_AGENT); __hip_atomic_fetch_max((unsigned*)(ctl + 32784), ~ts_, RLX_AGENT); }
#endif
#ifndef PHASE_MASK
#define PHASE_MASK 0x1ff
#endif
#define IN(k) (((PHASE_MASK >> (k)) & 1) && lo <= (k) && (k) < hi_ph)
#ifndef PROBE_DUP
#define PROBE_DUP 0
#endif
#define REP(k) ((((PROBE_DUP) >> (k)) & 1) ? 2 : 1)
#if TPROBE == 7
#define GRID_BAR(k) do { if (IN(k) && IN((k) + 1)) { xcd_barrier(bar); const long long tb_ = TP_T(); if ((k) == TPHASE) tacc += tb_ - tprev; tprev = tb_; } } while (0)
#elif TPROBE == 6
#define GRID_BAR(k) do { if (IN(k) && IN((k) + 1)) { const long long tb_ = TP_T(); xcd_barrier(bar); if ((k) == TPHASE) tacc += TP_T() - tb_; } } while (0)
#else
#define GRID_BAR(k) do { if (IN(k) && IN((k) + 1)) xcd_barrier(bar); } while (0)
#endif

    for (int rep_ = 0; rep_ < REP(0); ++rep_) if (IN(0)) {
        LAS float* scr = (LAS float*)(lds + RING_OFF + wave * 16384);
        constexpr int I_IN = (DM / 64) * (NPROJ / 32), I_OUT = (DM / 64) * (DM / 32);
        constexpr int NITEMS = I_IN + I_OUT;
        static_assert(BG_MODE == 3, "the expert weights are converted in the background of P2 only");
        for (int it = gw; it < NITEMS; it += NGW) {
            int r = it;
            if (r < I_IN) { p0_direct_item<1>(w_in, DM, NPROJ, BTIN, r, lane); continue; } r -= I_IN;
            p0_direct_item<0>(w_out, DM, DM, BTOUT, r, lane);
        }
        { const GAS f32x4* gr = (const GAS f32x4*)attn_norm_g + lane;
          f32x4 nx[8];
          if (gw < NTOK) { const GAS f32x4* xr = (const GAS f32x4*)(x + (size_t)gw * DM) + lane;
#pragma unroll
              for (int j = 0; j < 8; ++j) nx[j] = xr[64 * j]; }
          for (int m = gw; m < NTOK; m += NGW) {
            f32x4 v[8]; float s = 0.f;
#pragma unroll
            for (int j = 0; j < 8; ++j) { v[j] = nx[j]; s += (v[j].x * v[j].x + v[j].y * v[j].y) + (v[j].z * v[j].z + v[j].w * v[j].w); }
            if (m + NGW < NTOK) { const GAS f32x4* xr = (const GAS f32x4*)(x + (size_t)(m + NGW) * DM) + lane;
#pragma unroll
                for (int j = 0; j < 8; ++j) nx[j] = xr[64 * j]; }
            const float srt = sqrtf(wave_sum(s) * (1.0f / DM) + EPS), rs = 1.0f / srt;
            if (lane == 0) irs1[m] = srt;
            GAS unsigned long long* o8 = (GAS unsigned long long*)(XN + (size_t)m * DM) + lane;
#pragma unroll
            for (int j = 0; j < 8; ++j) { const f32x4 g = gr[64 * j]; o8[64 * j] = (unsigned long long)pk2(v[j].x * rs * g.x, v[j].y * rs * g.y) | ((unsigned long long)pk2(v[j].z * rs * g.z, v[j].w * rs * g.w) << 32); }
          }
        }
        for (int i = blockIdx.x * 512 + tid; i < SEQ * 32; i += G * 512) { const int pos = i >> 5, t = i & 31;
            const float f = __builtin_amdgcn_exp2f(-(float)t * (13.287712379549449f / 32.0f));
            double rev = (double)((float)pos * f) * 0.15915494309189535; rev -= __builtin_rint(rev);
            rope[i] = (f32x2){__builtin_amdgcn_cosf((float)rev), __builtin_amdgcn_sinf((float)rev)}; }
        for (int i = blockIdx.x * 512 + tid; i < 8 * 304; i += G * 512) { const int hh = i / 304, d = 207 - (i % 304); int bkt;
            if (d < 16) bkt = d < 0 ? 0 : d; else { const float lr = __logf((float)d / 16.0f) / 2.0794415416798357f; bkt = 16 + (int)(lr * 16.0f); bkt = bkt > 31 ? 31 : bkt; }
            tbw[i] = rel_bias[bkt * 8 + hh] * LOG2E; }
        for (int i = blockIdx.x * 512 + tid; i < 48 * DM; i += G * 512) { const int c = i / DM, k = i % DM; float w = 0.f;
            if (c < 4) w = w_gr[k * 4 + c]; else if (c < 36) { const int gq = (c - 4) >> 3, e = (c - 4) & 7; w = w_ir[((size_t)gq * DM + k) * 8 + e]; }
            const unsigned hb = f2bf(w); WRH[i] = (bf16)hb; WRL[i] = (bf16)f2bf(w - bf2f((unsigned short)hb)); }
    }
    GRID_BAR(0);

    if (IN(1)) {
        pg8::Gemm g{XN, BTIN, DM * 2, 0, nullptr}; pg8::StaticOrder S; S.init(NTOK, NPROJ, G, (int)blockIdx.x, REP(1));
        pg8::EpiProj E{PROJ, rope};
        pg8::gemm_phase<pg8::EpiProj, pg8::StaticOrder>(lds + RING_OFF, g, S, E, TPHASE == 1 ? tacc : tdum);
    }
    GRID_BAR(1);

    if (IN(2)) {
        float s1 = 0.f, s2 = 0.f;
        if (lane < 64) { s1 = lq1[lane] * lk1[lane]; s2 = lq2[lane] * lk2[lane]; }
        s1 = wave_sum(s1); s2 = wave_sum(s2);
        const float lam = __expf(s1) - __expf(s2) + 0.2f;
        att::Args A{PROJ, MIX, tbw, subln_g, gn_g, lam};
        att::Bg BG; BG.wg = w_gate; BG.wu = w_up; BG.wd = w_down; BG.btgu = BTGU; BG.btd = BTD; BG.have = false;
        { constexpr int NBG = NEXP * 3 * 1024; const int per = (NBG + NGW - 1) / NGW; BG.it = gw * per; BG.end = BG.it + per < NBG ? BG.it + per : NBG; if (BG.it > NBG) BG.it = NBG; }
#pragma unroll
        for (int j = 0; j < 8; ++j) BG.r[j] = (f32x4){0.f, 0.f, 0.f, 0.f};
        for (int it0 = vcu; it0 < 256 * REP(2); it0 += G) { const int it = it0 & 255;
            const int bh = it >> 2, s = it & 3, b = bh >> 3, h = bh & 7;
            for (int i = 0; i < 2; ++i) { const int qb = i ? s : 7 - s;
#ifndef NO_M0
                att::attn_unit<0>(A, BG, b, h, qb, lds);
#endif
#ifndef NO_M1
                att::attn_unit<1>(A, BG, b, h, qb, lds);
#endif
            }
        }
        for (;;) { att::bg_retire(BG, lane); if (BG.it >= BG.end) break; att::bg_issue(BG, lane); }
    }
    GRID_BAR(2);

    if (IN(3)) {
        pg8::Gemm g{MIX, BTOUT, DM * 2, 0, nullptr}; pg8::StaticOrder S; S.init(NTOK, DM, G, (int)blockIdx.x, REP(3));
        pg8::EpiRes E{XN, irs1, attn_norm_g, X1, XG, ffn_norm_g};
        pg8::gemm_phase<pg8::EpiRes, pg8::StaticOrder>(lds + RING_OFF, g, S, E, TPHASE == 3 ? tacc : tdum);
    }
    GRID_BAR(3);

    if (IN(4)) {
        LAS float* lgp = (LAS float*)(lds + RING_OFF) + (wave >> 1) * 1600;
        LAS unsigned char* wst = lds + RING_OFF + 25600;
        LAS float* gst = (LAS float*)(lds + RING_OFF + 25600 + 192 * 528);
        LAS int* bcnt = (LAS int*)(lds + LDSCTL_OFF + 4096);
        const int r = lane & 15, q4 = lane >> 4, kh = wave & 1;
        for (int i = tid; i < DM / 4; i += 512) ((LAS f32x4*)gst)[i] = ((const f32x4*)ffn_norm_g)[i];
        for (int tb = vcu; tb < NTOK / 64; tb += G) {
            const int t0 = tb * 64 + (wave >> 1) * 16;
            f32x4 acc[3]; float ss;
#if TPROBE == 12 || TPROBE == 14
            const long long tp4_ = TP_T();
#endif
            if (tid < 64) bcnt[tid] = 0;
            for (int rep4_ = 0; rep4_ < REP(4); ++rep4_) {
            acc[0] = (f32x4){0.f, 0.f, 0.f, 0.f}; acc[1] = acc[0]; acc[2] = acc[0]; ss = 0.f;
            const bf16* xrow = X1 + (size_t)(t0 + r) * DM + kh * 1024 + 8 * q4;
            unsigned char* xgrow = XG + (size_t)(t0 + r) * DM + kh * 1024 + 8 * q4;
            const LAS float* gl_ = gst + kh * 1024 + 8 * q4;
            const LAS unsigned char* wl_ = wst + ((kh * 2) * 48 + r) * 528 + q4 * 16;
            const int srow = tid >> 5, sch = tid & 31;
            v4u wq[12], xq[8], xn_[8];
#define P4_WLOAD(c_) do { _Pragma("unroll") for (int i = 0; i < 12; ++i) { const int sel_ = i / 3, row_ = (i % 3) * 16 + srow; \
                wq[i] = *(const v4u*)(((sel_ & 1) ? WRL : WRH) + (size_t)row_ * DM + (sel_ >> 1) * 1024 + (c_) * 256 + sch * 8); } } while (0)
            P4_WLOAD(0);
#pragma unroll
            for (int j = 0; j < 8; ++j) xn_[j] = *(const v4u*)(xrow + 32 * j);
#pragma unroll 1
            for (int c = 0; c < 4; ++c) { const int kb = c * 256;
                __syncthreads();
#pragma unroll
                for (int i = 0; i < 12; ++i) *(LAS v4u*)(wst + ((i / 3) * 48 + (i % 3) * 16 + srow) * 528 + sch * 16) = wq[i];
#pragma unroll
                for (int j = 0; j < 8; ++j) xq[j] = xn_[j];
                __syncthreads();
                if (c < 3) { P4_WLOAD(c + 1);
#pragma unroll
                    for (int j = 0; j < 8; ++j) xn_[j] = *(const v4u*)(xrow + kb + 256 + 32 * j); }
                v2u xgq[8];
#pragma unroll
                for (int j8 = 0; j8 < 8; ++j8) { const int k0 = kb + 32 * j8;
                    const v4u xw = xq[j8];
                    const f32x4 xa = (f32x4){bf2f(xw.x & 0xffff), bf2f(xw.x >> 16), bf2f(xw.y & 0xffff), bf2f(xw.y >> 16)}, xb = (f32x4){bf2f(xw.z & 0xffff), bf2f(xw.z >> 16), bf2f(xw.w & 0xffff), bf2f(xw.w >> 16)};
                    const f32x4 ga = *(const LAS f32x4*)(gl_ + k0), gb = *(const LAS f32x4*)(gl_ + k0 + 4);
                    float hv[8] = {xa[0] * ga[0], xa[1] * ga[1], xa[2] * ga[2], xa[3] * ga[3], xb[0] * gb[0], xb[1] * gb[1], xb[2] * gb[2], xb[3] * gb[3]};
                    ss += (xa[0] * xa[0] + xa[1] * xa[1]) + (xa[2] * xa[2] + xa[3] * xa[3]) + (xb[0] * xb[0] + xb[1] * xb[1]) + (xb[2] * xb[2] + xb[3] * xb[3]);
                    unsigned hb[8], lb[8];
#pragma unroll
                    for (int j = 0; j < 8; ++j) { hb[j] = f2bf(hv[j]); lb[j] = f2bf(hv[j] - bf2f((unsigned short)hb[j])); }
                    const v4u ahw = (v4u){hb[0] | (hb[1] << 16), hb[2] | (hb[3] << 16), hb[4] | (hb[5] << 16), hb[6] | (hb[7] << 16)};
                    const v4u alw = (v4u){lb[0] | (lb[1] << 16), lb[2] | (lb[3] << 16), lb[4] | (lb[5] << 16), lb[6] | (lb[7] << 16)};
                    xgq[j8].x = pk4_fp8(hv[0], hv[1], hv[2], hv[3]); xgq[j8].y = pk4_fp8(hv[4], hv[5], hv[6], hv[7]);
                    const bf16x8 ah = __builtin_bit_cast(bf16x8, ahw), al = __builtin_bit_cast(bf16x8, alw);
#pragma unroll
                    for (int cb = 0; cb < 3; ++cb) {
                        const bf16x8 bh = *(const LAS bf16x8*)(wl_ + cb * 16 * 528 + j8 * 64), bl = *(const LAS bf16x8*)(wl_ + (48 + cb * 16) * 528 + j8 * 64);
                        acc[cb] = __builtin_amdgcn_mfma_f32_16x16x32_bf16(ah, bh, acc[cb], 0, 0, 0);
                        acc[cb] = __builtin_amdgcn_mfma_f32_16x16x32_bf16(al, bh, acc[cb], 0, 0, 0);
                        acc[cb] = __builtin_amdgcn_mfma_f32_16x16x32_bf16(ah, bl, acc[cb], 0, 0, 0);
                    }
                }
#pragma unroll
                for (int j8 = 0; j8 < 8; ++j8) *(v2u*)(xgrow + kb + 32 * j8) = xgq[j8];
            }
#undef P4_WLOAD
            }
#if TPROBE == 12
            tacc += TP_T() - tp4_;
#endif
#if TPROBE == 13
            const long long tp4_ = TP_T();
#endif
            ss += __shfl_xor(ss, 16); ss += __shfl_xor(ss, 32);
            if (kh == 1) {
#pragma unroll
                for (int cb = 0; cb < 3; ++cb)
#pragma unroll
                    for (int i = 0; i < 4; ++i) lgp[768 + lane * 13 + cb * 4 + i] = acc[cb][i];
                lgp[768 + lane * 13 + 12] = ss;
            }
            __syncthreads();
            int e0 = 0, e1 = 0, lr0 = 0, lr1 = 0; float gt0 = 0.f, gt1 = 0.f, rs2 = 0.f;
            if (kh == 0) {
#pragma unroll
                for (int cb = 0; cb < 3; ++cb)
#pragma unroll
                    for (int i = 0; i < 4; ++i) lgp[(4 * q4 + i) * 48 + cb * 16 + r] = acc[cb][i] + lgp[768 + lane * 13 + cb * 4 + i];
                ss += lgp[768 + lane * 13 + 12];
                rs2 = 1.0f / sqrtf(ss * (1.0f / DM) + EPS);
                LDS_WAIT(); asm volatile("" ::: "memory");
                if (lane < 16) {
                    const LAS float* L = lgp + lane * 48;
                    float gl[4]; int gi = 0; float gmx = -INFINITY;
#pragma unroll
                    for (int g = 0; g < 4; ++g) { gl[g] = rs2 * L[g] + b_group[g]; if (gl[g] > gmx) { gmx = gl[g]; gi = g; } }
                    float den = 0.f;
#pragma unroll
                    for (int g = 0; g < 4; ++g) den += __expf(gl[g] - gmx);
                    const float pg = 1.0f / den;
                    int i0 = 0, i1 = 0; float v0 = -INFINITY, v1 = -INFINITY;
#pragma unroll
                    for (int e = 0; e < 8; ++e) { const float v = rs2 * L[4 + 8 * gi + e] + b_inner[gi * 8 + e]; if (v > v0) { v1 = v0; i1 = i0; v0 = v; i0 = e; } else if (v > v1) { v1 = v; i1 = e; } }
                    const float w0 = 1.0f / (1.0f + __expf(v1 - v0)), w1 = 1.0f - w0;
                    e0 = 8 * gi + i0; e1 = 8 * gi + i1; gt0 = pg * w0; gt1 = pg * w1;
                    lr0 = __hip_atomic_fetch_add(bcnt + e0, 1, __ATOMIC_RELAXED, __HIP_MEMORY_SCOPE_WORKGROUP);
                    lr1 = __hip_atomic_fetch_add(bcnt + e1, 1, __ATOMIC_RELAXED, __HIP_MEMORY_SCOPE_WORKGROUP);
                }
            }
            LDS_WAIT(); __syncthreads();
            if (tid < 32) { const int c = bcnt[tid]; bcnt[32 + tid] = c > 0 ? (int)__hip_atomic_fetch_add((unsigned*)(ctl + CW_CNT + 16 * tid), (unsigned)c, RLX_AGENT) : 0; }
            LDS_WAIT(); __syncthreads();
            if (kh == 0 && lane < 16) { const int tok = t0 + lane; const int rk0 = bcnt[32 + e0] + lr0, rk1 = bcnt[32 + e1] + lr1;
                tok_e[2 * tok] = e0; tok_e[2 * tok + 1] = e1; tok_rank[2 * tok] = rk0; tok_rank[2 * tok + 1] = rk1;
                lst_tok[e0 * pg8::LCAP + rk0] = tok; lst_rs[e0 * pg8::LCAP + rk0] = rs2; lst_gate[e0 * pg8::LCAP + rk0] = gt0;
                lst_tok[e1 * pg8::LCAP + rk1] = tok; lst_rs[e1 * pg8::LCAP + rk1] = rs2; lst_gate[e1 * pg8::LCAP + rk1] = gt1;
            }
            LDS_WAIT(); __syncthreads();
#if TPROBE == 13 || TPROBE == 14
            VM_WAIT(); tacc += TP_T() - tp4_;
#endif
        }
    }
    GRID_BAR(4);

    if (IN(6) || IN(7) || IN(8)) {
        if (tid == 0) { int off = 0, nt = 0;
            for (int e = 0; e < NEXP; ++e) { const int c = (int)__hip_atomic_load((unsigned*)(ctl + CW_CNT + 16 * e), RLX_AGENT); const int pc = (c + 255) >> 8;
                LTAB[e] = off; LTAB[96 + e] = c; for (int i = 0; i < pc; ++i) LTAB[128 + nt + i] = e; nt += pc; off += pc * 256; }
            LTAB[32] = nt; }
        __syncthreads();
    }
    {
        const int U = LTAB[32] * 8, R = U / G, rem = U - R * G, E = G - rem;
        const bool mixed = (FORCE_NOMIX == 0) && (N_LAUNCHES == 1) && IN(6) && IN(7) && R >= 1 && rem > 0 && 2 * rem <= G && (PROBE_DUP & 0xC0) == 0;
        const pg8::Gemm g6{XG, BTGU, DM, (size_t)2048 * DM, lst_tok}; const pg8::EpiSwiglu E6{ACT, lst_rs};
        const pg8::Gemm g7{ACT, BTD, FF, (size_t)DM * FF, nullptr}; const pg8::EpiDown E7{Y, lst_gate};
        if (mixed) {
            { pg8::GroupOrder S{LTAB[32], 8, G, vcu, LTAB, 0, R * G}; pg8::gemm_phase<pg8::EpiSwiglu, pg8::GroupOrder, true, true, 122, 127>(lds + RING_OFF, g6, S, E6, TPHASE == 6 ? tacc : tdum); }
            xcd_barrier(bar);
            if (vcu < rem) { pg8::GroupOrder S{LTAB[32], 8, G, vcu, LTAB, R * G, U}; pg8::gemm_phase<pg8::EpiSwiglu, pg8::GroupOrder, true, true, 122, 127>(lds + RING_OFF, g6, S, E6, TPHASE == 6 ? tacc : tdum); }
            else { pg8::GroupOrder S{LTAB[32], 8, G, vcu, LTAB, -rem, E}; pg8::gemm_phase<pg8::EpiDown, pg8::GroupOrder, false, true, 122, 127>(lds + RING_OFF, g7, S, E7, TPHASE == 7 ? tacc : tdum); }
            xcd_barrier(bar);
            { pg8::GroupOrder S{LTAB[32], 8, G, vcu, LTAB, E, U}; pg8::gemm_phase<pg8::EpiDown, pg8::GroupOrder, false, true, 122, 127>(lds + RING_OFF, g7, S, E7, TPHASE == 7 ? tacc : tdum); }
        } else {
            for (int rep_ = 0; rep_ < REP(6); ++rep_) if (IN(6)) { pg8::GroupOrder S{LTAB[32], 8, G, vcu, LTAB, 0, U}; pg8::gemm_phase<pg8::EpiSwiglu, pg8::GroupOrder, true, true, 122, 127>(lds + RING_OFF, g6, S, E6, TPHASE == 6 ? tacc : tdum); }
            GRID_BAR(6);
            for (int rep_ = 0; rep_ < REP(7); ++rep_) if (IN(7)) { pg8::GroupOrder S{LTAB[32], 8, G, vcu, LTAB, 0, U}; pg8::gemm_phase<pg8::EpiDown, pg8::GroupOrder, false, true, 122, 127>(lds + RING_OFF, g7, S, E7, TPHASE == 7 ? tacc : tdum); }
        }
    }
    GRID_BAR(7);

    for (int rep_ = 0; rep_ < REP(8); ++rep_) if (IN(8)) {
        unsigned poison = (__hip_atomic_load(ctl + CW_BAR + XB_TMO, RLX_AGENT) != 0u);
        int myd0 = 0, myd1 = 0;
        { const int m = gw + lane * NGW; if (m < NTOK) { myd0 = LTAB[tok_e[2 * m]] + tok_rank[2 * m]; myd1 = LTAB[tok_e[2 * m + 1]] + tok_rank[2 * m + 1]; } }
        const GAS f32x4* gr = (const GAS f32x4*)final_g + lane;
        v2u xv[8]; unsigned ya[8], yc[8];
#define P8_LOAD(i_) do { const int m_ = gw + (i_) * NGW; const int d0_ = __shfl(myd0, (i_)), d1_ = __shfl(myd1, (i_)); \
            const GAS v2u* xr_ = (const GAS v2u*)(X1 + (size_t)m_ * DM) + lane; const GAS unsigned* y0_ = (const GAS unsigned*)(Y + (size_t)d0_ * DM) + lane; const GAS unsigned* y1_ = (const GAS unsigned*)(Y + (size_t)d1_ * DM) + lane; \
            _Pragma("unroll") for (int j = 0; j < 8; ++j) { xv[j] = xr_[64 * j]; ya[j] = y0_[64 * j]; yc[j] = y1_[64 * j]; } } while (0)
        if (gw < NTOK) P8_LOAD(0);
        for (int i = 0, m = gw; m < NTOK; m += NGW, ++i) {
            f32x4 v[8]; float s = 0.f;
#pragma unroll
            for (int j = 0; j < 8; ++j) { const int a = (int)ya[j], c = (int)yc[j]; constexpr float iy = 1.0f / YSCALE;
                v[j].x = bf2f(xv[j].x & 0xffff) + (__builtin_amdgcn_cvt_f32_fp8(a, 0) + __builtin_amdgcn_cvt_f32_fp8(c, 0)) * iy; v[j].y = bf2f(xv[j].x >> 16) + (__builtin_amdgcn_cvt_f32_fp8(a, 1) + __builtin_amdgcn_cvt_f32_fp8(c, 1)) * iy;
                v[j].z = bf2f(xv[j].y & 0xffff) + (__builtin_amdgcn_cvt_f32_fp8(a, 2) + __builtin_amdgcn_cvt_f32_fp8(c, 2)) * iy; v[j].w = bf2f(xv[j].y >> 16) + (__builtin_amdgcn_cvt_f32_fp8(a, 3) + __builtin_amdgcn_cvt_f32_fp8(c, 3)) * iy;
                s += (v[j].x * v[j].x + v[j].y * v[j].y) + (v[j].z * v[j].z + v[j].w * v[j].w); }
            if (m + NGW < NTOK) P8_LOAD(i + 1);
            float rs = 1.0f / sqrtf(wave_sum(s) * (1.0f / DM) + EPS);
            if (poison) rs = __builtin_nanf("");
            GAS f32x4* orow = (GAS f32x4*)(out + (size_t)m * DM) + lane;
#pragma unroll
            for (int j = 0; j < 8; ++j) { const f32x4 g = gr[64 * j]; orow[64 * j] = (f32x4){v[j].x * rs * g.x, v[j].y * rs * g.y, v[j].z * rs * g.z, v[j].w * rs * g.w}; }
        }
#undef P8_LOAD
    }
#if TPROBE == 7
    if (TPHASE == 8) tacc += TP_T() - tprev;
#endif
#if TPROBE == 9
    tacc += TP_T() - tprev;
#endif
#if TPROBE == 10
    tacc = (long long)(__hip_atomic_load((unsigned*)(ctl + 32768), RLX_AGENT) - ~__hip_atomic_load((unsigned*)(ctl + 32784), RLX_AGENT));
#endif
#if TPROBE == 11
    { __syncthreads(); if (tid == 0) { const unsigned ts_ = (unsigned)__builtin_amdgcn_s_memrealtime(); __hip_atomic_fetch_max((unsigned*)(ctl + 32768), ts_, RLX_AGENT); __hip_atomic_fetch_max((unsigned*)(ctl + 32784), ~ts_, RLX_AGENT); }
      __syncthreads(); xcd_barrier(bar);
      tacc = (long long)(__hip_atomic_load((unsigned*)(ctl + 32768), RLX_AGENT) - ~__hip_atomic_load((unsigned*)(ctl + 32784), RLX_AGENT)); }
#endif
#if TPROBE
    if (blockIdx.x == TBLK && tid < 64) { const long long t0_ = (long long)__builtin_amdgcn_s_memrealtime(), d_ = tacc * TAMP; while ((long long)__builtin_amdgcn_s_memrealtime() - t0_ < d_) __builtin_amdgcn_s_sleep(8); }
#endif
#undef IN
#undef GRID_BAR
}

extern "C" void kernel_launch(void* const* d_in, const int* in_sizes, int n_in, void* d_out, int out_size, void* d_ws, size_t ws_size, hipStream_t stream) {
    static int grid = 0;
    if (grid == 0) {
        if (n_in != 20 || in_sizes[0] != NTOK * DM || out_size != NTOK * DM || ws_size < WS_END) {
            fprintf(stderr, "kernel_launch: unexpected shapes: n_in %d in0 %d out %d ws %zu (need %zu); nothing launched\n", n_in, n_in > 0 ? in_sizes[0] : -1, out_size, ws_size, (size_t)WS_END); grid = -1; return; }
        int dev = 0, cus = 0, per_cu = 0;
        if (hipGetDevice(&dev) != hipSuccess || hipDeviceGetAttribute(&cus, hipDeviceAttributeMultiprocessorCount, dev) != hipSuccess) { fprintf(stderr, "kernel_launch: device query failed\n"); grid = -1; return; }
        if (hipFuncSetAttribute((const void*)hymba_fwd, hipFuncAttributeMaxDynamicSharedMemorySize, LDS_BYTES) != hipSuccess) { fprintf(stderr, "kernel_launch: hipFuncSetAttribute failed\n"); grid = -1; return; }
        if (hipOccupancyMaxActiveBlocksPerMultiprocessor(&per_cu, (const void*)hymba_fwd, 512, LDS_BYTES) != hipSuccess || per_cu < 1) {
            fprintf(stderr, "kernel_launch: occupancy query reports %d workgroups per CU\n", per_cu); per_cu = 1; }
        (void)hipGetLastError();
        grid = cus;
    }
    if (grid < 0) return;
    if (hipMemsetAsync((char*)d_ws + WS_CTL, 0, CTL_ZERO_BYTES, stream) != hipSuccess) { fprintf(stderr, "kernel_launch: memset failed\n"); return; }
    KArgs a{};
    for (int i = 0; i < 20; ++i) a.in[i] = (const float*)d_in[i];
    a.out = (float*)d_out; a.ws = (unsigned char*)d_ws;
    for (int li = 0; li < N_LAUNCHES; ++li) {
        a.ph_lo = (N_LAUNCHES == 1) ? 0 : li; a.ph_hi = (N_LAUNCHES == 1) ? N_PHASES : li + 1;
        hipLaunchKernelGGL(hymba_fwd, dim3(grid), dim3(512), LDS_BYTES, stream, a);
        const hipError_t le = hipPeekAtLastError();
        if (le != hipSuccess) { fprintf(stderr, "kernel_launch: launch %d failed: %s\n", li, hipGetErrorName(le)); break; }
    }
}
```

```cpp
#include <hip/hip_runtime.h>
#include <cstdio>
#include <cstdint>
#include <type_traits>

#ifndef BG_MODE
#define BG_MODE 3
#endif
#ifndef FORCE_NOMIX
#define FORCE_NOMIX 0
#endif
#ifndef MK_N_LAUNCHES
#define MK_N_LAUNCHES 1
#endif
constexpr int N_PHASES = 9;
constexpr int N_LAUNCHES = MK_N_LAUNCHES;

constexpr int BATCH = 8, SEQ = 2048, DM = 2048, NTOK = BATCH * SEQ;
constexpr int NPROJ = 6144;
constexpr int C_DQ = 0, C_DK = 1024, C_DV = 2048, C_RQ = 3072, C_RK = 3584, C_RV = 4096, C_RG = 5120;
constexpr int NEXP = 32, FF = 1024;
constexpr int XS_ROWS = 40960;
constexpr float EPS = 1e-6f;
constexpr float LOG2E = 1.4426950408889634f;
constexpr float YSCALE = 16.0f;
constexpr float QSCALE = 0.125f * LOG2E;

constexpr size_t MiB = 1u << 20;
constexpr size_t WS_CTL = 0, CTL_ZERO_BYTES = 1 * MiB;
constexpr size_t WS_ROPE = 1 * MiB;
constexpr size_t WS_TB = 1 * MiB + 512 * 1024;
constexpr size_t WS_WRH = 2 * MiB, WS_WRL = 2 * MiB + 256 * 1024;
constexpr size_t WS_TOK = 3 * MiB;
constexpr size_t TOK_E = 0, TOK_RANK = 128 * 1024, TOK_GATE = 256 * 1024, TOK_RS2 = 384 * 1024, TOK_POS = 448 * 1024, ROW_GATE = 576 * 1024, ROW_RS = 736 * 1024;
constexpr size_t WS_SROW = 2 * MiB + 512 * 1024;
constexpr size_t WS_BTIN = 4 * MiB, WS_BTOUT = 28 * MiB, WS_BTGU = 36 * MiB, WS_BTD = 292 * MiB;
constexpr size_t WS_XN = 420 * MiB, WS_MIX = 484 * MiB, WS_ACT = 420 * MiB;
constexpr size_t WS_PROJ = 548 * MiB, WS_Y = 548 * MiB, WS_XG = 708 * MiB;
constexpr size_t WS_X1 = 772 * MiB, WS_LST = 840 * MiB, WS_END = 900 * MiB;
constexpr int CW_TMO = 0, CW_CODE = 1, CW_BAR = 4096, CW_CNT = 16384;

constexpr int RING_OFF = 0, RING_BYTES = 131072;
constexpr int LDSCTL_OFF = 139264, MISC_OFF = LDSCTL_OFF + 320;
constexpr int LTAB_OFF = LDSCTL_OFF + 1024;
constexpr int LDS_BYTES = 147456;

#define GAS __attribute__((address_space(1)))
#define LAS __attribute__((address_space(3)))
typedef unsigned short bf16;
typedef unsigned v4u __attribute__((ext_vector_type(4)));
typedef unsigned v2u __attribute__((ext_vector_type(2)));
typedef float f32x4 __attribute__((ext_vector_type(4)));
typedef float f32x2 __attribute__((ext_vector_type(2)));
typedef float f32x16 __attribute__((ext_vector_type(16)));
typedef short bf16x8 __attribute__((ext_vector_type(8)));
typedef short s16x4 __attribute__((ext_vector_type(4)));
typedef GAS unsigned gu32;
#define RLX_AGENT __ATOMIC_RELAXED, __HIP_MEMORY_SCOPE_AGENT
#define LDS_WAIT() asm volatile("s_waitcnt lgkmcnt(0)" ::: "memory")
#define VM_WAIT() asm volatile("s_waitcnt vmcnt(0)" ::: "memory")

__device__ __forceinline__ unsigned f2bf(float f) { unsigned u = __builtin_bit_cast(unsigned, f); return (u + 0x7fffu + ((u >> 16) & 1u)) >> 16; }
__device__ __forceinline__ unsigned pk2(float lo, float hi) { return f2bf(lo) | (f2bf(hi) << 16); }
__device__ __forceinline__ float bf2f(unsigned short b) { return __builtin_bit_cast(float, (unsigned)b << 16); }
__device__ __forceinline__ unsigned cvt_pk_bf16(float lo, float hi) { unsigned r; asm volatile("v_cvt_pk_bf16_f32 %0, %1, %2" : "=v"(r) : "v"(lo), "v"(hi)); return r; }
__device__ __forceinline__ unsigned pk4_fp8(float a, float b, float c, float d) { unsigned w = 0u; w = (unsigned)__builtin_amdgcn_cvt_pk_fp8_f32(a, b, (int)w, false); w = (unsigned)__builtin_amdgcn_cvt_pk_fp8_f32(c, d, (int)w, true); return w; }
__device__ __forceinline__ float wave_sum(float v) {
#pragma unroll
    for (int o = 1; o < 64; o <<= 1) v += __shfl_xor(v, o);
    return v;
}

#ifndef TPROBE
#define TPROBE 0
#endif
#ifndef TPHASE
#define TPHASE 4
#endif
#ifndef TAMP
#define TAMP 8
#endif
#ifndef TBLK
#define TBLK 0
#endif
#define TP_T() ((long long)__builtin_amdgcn_s_memrealtime())
namespace pg8 {
#define PG8_LAS __attribute__((address_space(3)))
typedef unsigned short bf16_t;
typedef int v4i_t __attribute__((ext_vector_type(4)));
typedef int v8i_t __attribute__((ext_vector_type(8)));
constexpr int LCAP = 16384;
constexpr int BM = 256, BK = 64, HALF = 128, HTB = HALF * BK * 2, STAGE_BYTES = 8 * HTB, NXCD = 8, WGM = 8;
__host__ __device__ __forceinline__ int lds_byte(int r, int c) { const int st = (r >> 4) * 2 + (c >> 5), rr = r & 15, cc = c & 31, ob = rr * 64 + cc * 2; return st * 1024 + (ob ^ (((ob >> 9) & 1) << 5)); }
__host__ __device__ __forceinline__ void stage_rc(int b, int& R, int& C) { const int st = b / 1024, sb = b % 1024, swz = sb ^ (((sb >> 9) & 1) << 5); R = (st >> 1) * 16 + swz / 64; C = (st & 1) * 32 + (swz % 64) / 2; }
__host__ __device__ __forceinline__ int perm32(int rho) { const int n = rho >> 4, i = rho & 15; return 8 * (i >> 2) + 4 * n + (i & 3); }

struct Unit { int pm, pn, e, rl0, cnt; };
struct Gemm { const void* A; const void* Bt; int Kb; size_t bstride; const int* lst; };

struct StaticOrder {
    int nM, nN, nwg, G, c;
    int reps;
    __device__ void init(int M, int N, int G_, int c_, int reps_ = 1) { nM = M / BM; nN = N / BM; nwg = nM * nN; G = G_; c = c_; reps = reps_; }
    __device__ bool next(int i, Unit& u) const {
        const long L0 = (long)i * G + c; if (L0 >= (long)nwg * reps) return false;
        const long L = L0 % nwg;
        int wgid = (int)L; { const int q = nwg / NXCD, r = nwg % NXCD, xcd = wgid % NXCD, off = wgid / NXCD; wgid = (xcd < r ? xcd * (q + 1) : r * (q + 1) + (xcd - r) * q) + off; }
        const int nig = WGM * nN, gid = wgid / nig, fm = gid * WGM, gsz = (nM - fm) < WGM ? (nM - fm) : WGM;
        u.pm = fm + ((wgid % nig) % gsz); u.pn = (wgid % nig) / gsz; u.e = 0; u.rl0 = 0; u.cnt = 0; return true;
    }
};
struct GroupOrder {
    int ntiles, nN, G, c; const PG8_LAS int* tab;
    int L0, Lend;
    __device__ bool next(int i, Unit& u) const {
        const int L = L0 + i * G + c; if (L < 0 || L >= Lend) return false;
        const int t = L / nN; u.pm = t; u.pn = L - t * nN; u.e = __builtin_amdgcn_readfirstlane(tab[128 + t]);
        u.rl0 = t * BM - __builtin_amdgcn_readfirstlane(tab[u.e]); u.cnt = __builtin_amdgcn_readfirstlane(tab[96 + u.e]); return true;
    }
};

template <class Epi, class Sched, bool GATHER = false, bool F8 = false, int SA = 127, int SB = 127>
__device__ __forceinline__ void gemm_phase(PG8_LAS unsigned char* lds, const Gemm g, const Sched& S, const Epi& E, long long& tacc) {
#if TPROBE == 3
    const long long tp_entry = TP_T();
#endif
#if TPROBE
    long long tp_a = 0;
#endif
    const int tid = threadIdx.x, wid = __builtin_amdgcn_readfirstlane(tid >> 6), lane = tid & 63, wr = wid >> 2, wc = wid & 3, fr = lane & 15, fq = lane >> 4;
    const int Kb = g.Kb, nt = Kb / 128;
    unsigned voffA[2], voffB[2];
#pragma unroll
    for (int i = 0; i < 2; ++i) { int R, C; stage_rc(tid * 16 + i * 8192, R, C); const int Rb = Epi::PERM ? ((R & ~31) + perm32(R & 31)) : R;
        voffA[i] = (unsigned)(R * Kb + C * 2); voffB[i] = (unsigned)(Rb * Kb + C * 2); }
    unsigned vC[2][2], vN[2][2];
#define PG8_GOFF(dst, u_) do { _Pragma("unroll") for (int _h = 0; _h < 2; ++_h) _Pragma("unroll") for (int _i = 0; _i < 2; ++_i) { int R_, C_; stage_rc(tid * 16 + _i * 8192, R_, C_); \
        const int rl_ = (u_).rl0 + _h * HALF + R_; const int tk_ = rl_ < (u_).cnt ? g.lst[(u_).e * LCAP + rl_] : 0; dst[_h][_i] = (unsigned)(tk_ * Kb + C_ * 2); } } while (0)
    const size_t kstep = (size_t)(BK * 2);
    const size_t hstep = (size_t)HALF * Kb;
    const size_t tstep = 2 * hstep;
    const unsigned ldsw = (unsigned)wid * 1024u;
    const int aoff = lds_byte(wr * 64 + fr, fq * 8), boff = lds_byte(wc * 32 + fr, fq * 8);
#define PG8_SA(b, h) (((b) * 2 + (h)) * HTB)
#define PG8_SB(b, h) ((4 + (b) * 2 + (h)) * HTB)
#define PG8_STAGE(bufoff, gbase, voff) do { _Pragma("unroll") for (int _i = 0; _i < 2; ++_i) \
        __builtin_amdgcn_global_load_lds((const unsigned*)((const char*)(gbase) + (voff)[_i]), (PG8_LAS unsigned*)(lds + (bufoff) + ldsw + _i * 8192), 16, 0, 0); } while (0)
#define PG8_STAGE_A(bufoff, gbase, hh, nx) do { if constexpr (GATHER) { _Pragma("unroll") for (int _i = 0; _i < 2; ++_i) { const unsigned _v = (nx) ? vN[hh][_i] : vC[hh][_i]; \
        __builtin_amdgcn_global_load_lds((const unsigned*)((const char*)(gbase) + _v), (PG8_LAS unsigned*)(lds + (bufoff) + ldsw + _i * 8192), 16, 0, 0); } } \
        else { PG8_STAGE(bufoff, (gbase) + (hh) * hstep, voffA); } } while (0)
#define PG8_LDA(dst, b, h) do { if constexpr (F8) { _Pragma("unroll") for (int m = 0; m < 4; ++m) { const v4i_t lo_ = *(const PG8_LAS v4i_t*)(lds + PG8_SA(b, h) + aoff + m * 2048), hi_ = *(const PG8_LAS v4i_t*)(lds + PG8_SA(b, h) + aoff + m * 2048 + 1024); \
            dst##8[m] = __builtin_shufflevector(lo_, hi_, 0, 1, 2, 3, 4, 5, 6, 7); } } \
        else { _Pragma("unroll") for (int m = 0; m < 4; ++m) _Pragma("unroll") for (int k = 0; k < 2; ++k) dst[m][k] = *(const PG8_LAS bf16x8*)(lds + PG8_SA(b, h) + aoff + m * 2048 + k * 1024); } } while (0)
#define PG8_LDB(dst, b, h) do { if constexpr (F8) { _Pragma("unroll") for (int n = 0; n < 2; ++n) { const v4i_t lo_ = *(const PG8_LAS v4i_t*)(lds + PG8_SB(b, h) + boff + n * 2048), hi_ = *(const PG8_LAS v4i_t*)(lds + PG8_SB(b, h) + boff + n * 2048 + 1024); \
            dst##8[n] = __builtin_shufflevector(lo_, hi_, 0, 1, 2, 3, 4, 5, 6, 7); } } \
        else { _Pragma("unroll") for (int n = 0; n < 2; ++n) _Pragma("unroll") for (int k = 0; k < 2; ++k) dst[n][k] = *(const PG8_LAS bf16x8*)(lds + PG8_SB(b, h) + boff + n * 2048 + k * 1024); } } while (0)
#define PG8_MMA(ai, bj, At, Bt) do { __builtin_amdgcn_s_setprio(1); \
        if constexpr (F8) { _Pragma("unroll") for (int m = 0; m < 4; ++m) _Pragma("unroll") for (int n = 0; n < 2; ++n) \
            asm volatile("v_mfma_scale_f32_16x16x128_f8f6f4 %0, %1, %2, %0, %3, %4 op_sel_hi:[0,0,0]" : "+v"(acc[ai][bj][m][n]) : "v"(Bt##8[n]), "v"(At##8[m]), "v"(sca), "v"(scb)); } \
        else { _Pragma("unroll") for (int m = 0; m < 4; ++m) _Pragma("unroll") for (int n = 0; n < 2; ++n) _Pragma("unroll") for (int k = 0; k < 2; ++k) \
            acc[ai][bj][m][n] = __builtin_amdgcn_mfma_f32_16x16x32_bf16(Bt[n][k], At[m][k], acc[ai][bj][m][n], 0, 0, 0); } \
        __builtin_amdgcn_s_setprio(0); } while (0)
#define PG8_WAIT_V(n) asm volatile("s_waitcnt vmcnt(" #n ")" ::: "memory")
#define PG8_WAIT_L(n) asm volatile("s_waitcnt lgkmcnt(" #n ")" ::: "memory")
#define PG8_BAR __builtin_amdgcn_s_barrier()
#define PG8_SCHED __builtin_amdgcn_sched_barrier(0)
    Unit cur, nxt; int ui = 0;
    if (!S.next(0, cur)) return;
    f32x4 acc[2][2][4][2];
#pragma unroll
    for (int a = 0; a < 2; ++a)
#pragma unroll
        for (int b = 0; b < 2; ++b)
#pragma unroll
            for (int m = 0; m < 4; ++m)
#pragma unroll
                for (int n = 0; n < 2; ++n) acc[a][b][m][n] = (f32x4){0.f, 0.f, 0.f, 0.f};
    const int sca = SA, scb = SB;
    bf16x8 At[4][2], B0[2][2], B1[2][2]; v8i_t At8[4], B08[2], B18[2];
    const char* cA = GATHER ? (const char*)g.A : (const char*)g.A + (size_t)cur.pm * tstep; const char* cB = (const char*)g.Bt + (size_t)cur.e * g.bstride + (size_t)cur.pn * tstep;
    if constexpr (GATHER) { PG8_GOFF(vC, cur); }
    PG8_STAGE(PG8_SB(0, 0), cB, voffB); PG8_STAGE(PG8_SB(0, 1), cB + hstep, voffB); PG8_STAGE_A(PG8_SA(0, 0), cA, 0, false); PG8_STAGE_A(PG8_SA(0, 1), cA, 1, false);
    if (wr == 1) PG8_BAR;
    PG8_WAIT_V(2); PG8_BAR;
    PG8_STAGE(PG8_SB(1, 0), cB + kstep, voffB); PG8_STAGE_A(PG8_SA(1, 0), cA + kstep, 0, false); PG8_STAGE(PG8_SB(1, 1), cB + hstep + kstep, voffB);
    PG8_WAIT_V(6); PG8_BAR;
    for (;;) {
        const bool has_next = S.next(ui + 1, nxt);
        const char* nA = GATHER ? cA : (has_next ? (const char*)g.A + (size_t)nxt.pm * tstep : cA);
        if constexpr (GATHER) { if (has_next) { PG8_GOFF(vN, nxt); } else {
#pragma unroll
            for (int _h = 0; _h < 2; ++_h)
#pragma unroll
                for (int _i = 0; _i < 2; ++_i) vN[_h][_i] = vC[_h][_i]; } }
        const char* nB = has_next ? (const char*)g.Bt + (size_t)nxt.e * g.bstride + (size_t)nxt.pn * tstep : cB;
#if TPROBE == 5
        if (ui > 0) tacc += TP_T() - tp_a;
#endif
#if TPROBE == 2
        tp_a = TP_T();
#endif
#pragma unroll 1
        for (int t = 0; t < nt; t += 2) {
#if TPROBE == 4
            if (t == 0) tp_a = TP_T();
#endif
            const bool last = (t == nt - 2);
            const char* a1 = cA + (size_t)(t + 1) * kstep;
            const char* a2 = last ? nA : cA + (size_t)(t + 2) * kstep; const char* b2 = last ? nB : cB + (size_t)(t + 2) * kstep;
            const char* a3 = a2 + kstep; const char* b3 = b2 + kstep;
            PG8_LDB(B0, 0, 0); PG8_LDB(B1, 0, 1); PG8_SCHED; PG8_LDA(At, 0, 0); PG8_STAGE_A(PG8_SA(1, 1), a1, 1, false);
            PG8_WAIT_V(8); PG8_WAIT_L(0); PG8_BAR; PG8_MMA(0, 0, At, B0); PG8_MMA(0, 1, At, B1); PG8_BAR; PG8_SCHED;
            PG8_LDA(At, 0, 1); PG8_STAGE(PG8_SB(0, 0), b2, voffB); PG8_STAGE(PG8_SB(0, 1), b2 + hstep, voffB); PG8_STAGE_A(PG8_SA(0, 0), a2, 0, last);
            PG8_WAIT_V(8); PG8_WAIT_L(0); PG8_BAR; PG8_MMA(1, 0, At, B0); PG8_MMA(1, 1, At, B1); PG8_BAR; PG8_SCHED;
            PG8_LDB(B0, 1, 0); PG8_LDB(B1, 1, 1); PG8_SCHED; PG8_LDA(At, 1, 0); PG8_STAGE_A(PG8_SA(0, 1), a2, 1, last);
            PG8_WAIT_V(8); PG8_WAIT_L(0); PG8_BAR; PG8_MMA(0, 0, At, B0); PG8_MMA(0, 1, At, B1); PG8_BAR; PG8_SCHED;
            PG8_LDA(At, 1, 1); PG8_STAGE(PG8_SB(1, 0), b3, voffB); PG8_STAGE(PG8_SB(1, 1), b3 + hstep, voffB); PG8_STAGE_A(PG8_SA(1, 0), a3, 0, last);
            PG8_WAIT_V(8); PG8_WAIT_L(0); PG8_BAR; PG8_MMA(1, 0, At, B0); PG8_MMA(1, 1, At, B1); PG8_BAR; PG8_SCHED;
#if TPROBE == 4
            if (t == 0) tacc += TP_T() - tp_a;
#endif
        }
#if TPROBE == 2
        tacc += TP_T() - tp_a;
#endif
#if TPROBE == 1
        tp_a = TP_T();
#endif
        if (wr == 0) PG8_BAR;
        if constexpr (F8) asm volatile("s_nop 15\n\ts_nop 15" ::: "memory");
        E(acc, cur, wr, wc, fr, fq);
#if TPROBE == 1
        tacc += TP_T() - tp_a;
#endif
#if TPROBE == 5
        tp_a = TP_T();
#endif
        if (!has_next) break;
#pragma unroll
        for (int a = 0; a < 2; ++a)
#pragma unroll
            for (int b = 0; b < 2; ++b)
#pragma unroll
                for (int m = 0; m < 4; ++m)
#pragma unroll
                    for (int n = 0; n < 2; ++n) acc[a][b][m][n] = (f32x4){0.f, 0.f, 0.f, 0.f};
        cur = nxt; cA = nA; cB = nB; ++ui;
        if constexpr (GATHER) {
#pragma unroll
            for (int _h = 0; _h < 2; ++_h)
#pragma unroll
                for (int _i = 0; _i < 2; ++_i) vC[_h][_i] = vN[_h][_i]; }
        if (wr == 1) PG8_BAR;
    }
    PG8_WAIT_V(0);
    PG8_BAR;
#if TPROBE == 3
    tacc += TP_T() - tp_entry;
#endif
#undef PG8_SA
#undef PG8_SB
#undef PG8_STAGE
#undef PG8_STAGE_A
#undef PG8_GOFF
#undef PG8_LDA
#undef PG8_LDB
#undef PG8_MMA
#undef PG8_WAIT_V
#undef PG8_WAIT_L
#undef PG8_BAR
#undef PG8_SCHED
}

struct EpiProj {
    static constexpr bool PERM = true;
    bf16_t* O; const f32x2* rope;
    __device__ __forceinline__ void operator()(const f32x4 (&acc)[2][2][4][2], const Unit& u, int wr, int wc, int fr, int fq) const {
        const int row0 = u.pm * BM + wr * 64 + fr, col0 = u.pn * BM + wc * 32 + 8 * fq;
        const int mode = (u.pn < 4) ? 1 : ((u.pn >= 12 && u.pn < 16) ? 2 : 0);
        const float sc = (mode == 1) ? QSCALE : ((u.pn >= 14 && u.pn < 16) ? 0.125f : 1.0f);
#pragma unroll
        for (int ai = 0; ai < 2; ++ai)
#pragma unroll
            for (int m = 0; m < 4; ++m) { const int row = row0 + ai * HALF + m * 16; bf16_t* rowp = O + (size_t)row * NPROJ + col0;
#pragma unroll
                for (int bj = 0; bj < 2; ++bj) { f32x4 v0 = acc[ai][bj][m][0], v1 = acc[ai][bj][m][1];
                    if (mode == 2) { const int t0 = ((col0 + bj * HALF) & 63) >> 1; const f32x4* rp = (const f32x4*)(rope + (size_t)(row & (SEQ - 1)) * 32 + t0);
                        const f32x4 c0 = rp[0], c1 = rp[1];
                        f32x4 w0, w1;
                        w0[0] = v0[0] * c0[0] - v0[1] * c0[1]; w0[1] = v0[0] * c0[1] + v0[1] * c0[0];
                        w0[2] = v0[2] * c0[2] - v0[3] * c0[3]; w0[3] = v0[2] * c0[3] + v0[3] * c0[2];
                        w1[0] = v1[0] * c1[0] - v1[1] * c1[1]; w1[1] = v1[0] * c1[1] + v1[1] * c1[0];
                        w1[2] = v1[2] * c1[2] - v1[3] * c1[3]; w1[3] = v1[2] * c1[3] + v1[3] * c1[2];
                        v0 = w0; v1 = w1; }
                    v0 = v0 * sc; v1 = v1 * sc; v4u w; w.x = cvt_pk_bf16(v0[0], v0[1]); w.y = cvt_pk_bf16(v0[2], v0[3]); w.z = cvt_pk_bf16(v1[0], v1[1]); w.w = cvt_pk_bf16(v1[2], v1[3]);
                    *(v4u*)(rowp + bj * HALF) = w; } }
    }
};
struct EpiRes {
    static constexpr bool PERM = true;
    const bf16_t* xn; const float* irs1; const float* g1; bf16_t* X1; unsigned char* XG; const float* g2;
    __device__ __forceinline__ void operator()(const f32x4 (&acc)[2][2][4][2], const Unit& u, int wr, int wc, int fr, int fq) const {
        const int row0 = u.pm * BM + wr * 64 + fr, col0 = u.pn * BM + wc * 32 + 8 * fq;
        f32x4 ig[2][2];
#pragma unroll
        for (int bj = 0; bj < 2; ++bj)
#pragma unroll
            for (int n = 0; n < 2; ++n) { const f32x4 t = *(const f32x4*)(g1 + col0 + bj * HALF + 4 * n); ig[bj][n] = (f32x4){1.0f / t[0], 1.0f / t[1], 1.0f / t[2], 1.0f / t[3]}; }
#pragma unroll
        for (int ai = 0; ai < 2; ++ai) {
            v4u xb[4][2]; float ir[4];
#pragma unroll
            for (int m = 0; m < 4; ++m) { ir[m] = irs1[row0 + ai * HALF + m * 16];
#pragma unroll
                for (int bj = 0; bj < 2; ++bj) xb[m][bj] = *(const v4u*)(xn + (size_t)(row0 + ai * HALF + m * 16) * DM + col0 + bj * HALF); }
#pragma unroll
            for (int m = 0; m < 4; ++m) { const size_t off = (size_t)(row0 + ai * HALF + m * 16) * DM + col0;
#pragma unroll
                for (int bj = 0; bj < 2; ++bj) { const v4u xw = xb[m][bj]; const float rr = ir[m];
                    const f32x4 x0 = (f32x4){bf2f(xw.x & 0xffff), bf2f(xw.x >> 16), bf2f(xw.y & 0xffff), bf2f(xw.y >> 16)} * ig[bj][0] * rr, x1 = (f32x4){bf2f(xw.z & 0xffff), bf2f(xw.z >> 16), bf2f(xw.w & 0xffff), bf2f(xw.w >> 16)} * ig[bj][1] * rr;
                    const f32x4 v0 = x0 + acc[ai][bj][m][0], v1 = x1 + acc[ai][bj][m][1];
                    v4u w; w.x = cvt_pk_bf16(v0[0], v0[1]); w.y = cvt_pk_bf16(v0[2], v0[3]); w.z = cvt_pk_bf16(v1[0], v1[1]); w.w = cvt_pk_bf16(v1[2], v1[3]);
                    *(v4u*)(X1 + off + bj * HALF) = w;
                } } }
    }
};
struct EpiSwiglu {
    static constexpr bool PERM = true;
    unsigned char* O; const float* lst_rs;
    __device__ __forceinline__ void operator()(const f32x4 (&acc)[2][2][4][2], const Unit& u, int wr, int wc, int fr, int fq) const {
        const int row0 = u.pm * BM + wr * 64 + fr, f0 = u.pn * 128 + wc * 16 + 4 * fq;
#pragma unroll
        for (int ai = 0; ai < 2; ++ai)
#pragma unroll
            for (int m = 0; m < 4; ++m) { const int row = row0 + ai * HALF + m * 16; const float rs = lst_rs[u.e * LCAP + u.rl0 + (row - u.pm * BM)]; unsigned char* rowp = O + (size_t)row * FF + f0;
#pragma unroll
                for (int bj = 0; bj < 2; ++bj) { const f32x4 a = acc[ai][bj][m][0] * rs, b = acc[ai][bj][m][1] * rs; f32x4 r;
#pragma unroll
                    for (int j = 0; j < 4; ++j) r[j] = a[j] * __builtin_amdgcn_rcpf(1.0f + __builtin_amdgcn_exp2f(-a[j] * LOG2E)) * b[j];
                    *(unsigned*)(rowp + bj * 64) = pk4_fp8(r[0], r[1], r[2], r[3]); } }
    }
};
struct EpiDown {
    static constexpr bool PERM = true;
    unsigned char* O; const float* lst_gate;
    __device__ __forceinline__ void operator()(const f32x4 (&acc)[2][2][4][2], const Unit& u, int wr, int wc, int fr, int fq) const {
        const int row0 = u.pm * BM + wr * 64 + fr, col0 = u.pn * BM + wc * 32 + 8 * fq;
#pragma unroll
        for (int ai = 0; ai < 2; ++ai)
#pragma unroll
            for (int m = 0; m < 4; ++m) { const int row = row0 + ai * HALF + m * 16; const float gt = lst_gate[u.e * LCAP + u.rl0 + (row - u.pm * BM)] * YSCALE; unsigned char* rowp = O + (size_t)row * DM + col0;
#pragma unroll
                for (int bj = 0; bj < 2; ++bj) { const f32x4 v0 = acc[ai][bj][m][0] * gt, v1 = acc[ai][bj][m][1] * gt;
                    v2u w; w.x = pk4_fp8(v0[0], v0[1], v0[2], v0[3]); w.y = pk4_fp8(v1[0], v1[1], v1[2], v1[3]);
                    *(v2u*)(rowp + bj * HALF) = w; } }
    }
};
}

namespace att {
constexpr int KOFF0 = 0, KOFF1 = 8192, VOFF = 16384, BUFB = 32768;
constexpr int TBOFF = 65536, WSFOFF = 66816, QFOFF0 = 69632, QFOFF1 = 98304;
constexpr int STG_PITCH = 132, STG_WAVE = 32 * STG_PITCH * 4;
constexpr float THR = 8.0f;
__device__ __forceinline__ int crow(int r, int hi) { return (r & 3) + 8 * (r >> 2) + 4 * hi; }
__device__ __forceinline__ s16x4 vtr(const LAS unsigned char* p) { typedef short v4i16_t __attribute__((ext_vector_type(4))); return __builtin_bit_cast(s16x4, __builtin_amdgcn_ds_read_tr16_b64_v4i16((LAS v4i16_t*)p)); }

struct Args { const bf16* proj; bf16* mix; const float* tb; const float* subln_g; const float* gn_g; float lam; };

#define ATT_SRC(L) unsigned ksrc, vsrc; \
    { const int row_ = 8 * wid + ((L) >> 3), slot_ = (L) & 7, ch_ = slot_ ^ ((row_ >> 1) & 7); ksrc = (unsigned)(row_ * NPROJ + ck + ch_ * 8) * 2u; } \
    { const int row_ = 8 * wid + ((L) >> 4), slot_ = (L) & 15; vsrc = (unsigned)(row_ * NPROJ + cv + ((slot_ ^ ((row_ & 3) << 2)) * 8)) * 2u; }
#define ATT_STAGE(t, bufo) do { const char* _b = pbase + (size_t)(t) * 64 * NPROJ * 2; \
        __builtin_amdgcn_global_load_lds((const unsigned*)(_b + ksrc), (LAS unsigned*)(lds + (bufo) + KOFF0 + ldsw), 16, 0, 0); \
        if (MODE == 0) __builtin_amdgcn_global_load_lds((const unsigned*)(_b + ksrc + 128), (LAS unsigned*)(lds + (bufo) + KOFF1 + ldsw), 16, 0, 0); \
        __builtin_amdgcn_global_load_lds((const unsigned*)(_b + vsrc), (LAS unsigned*)(lds + (bufo) + VOFF + 2 * ldsw), 16, 0, 0); \
        __builtin_amdgcn_global_load_lds((const unsigned*)(_b + vsrc + 4 * NPROJ * 2), (LAS unsigned*)(lds + (bufo) + VOFF + 2 * ldsw + 1024), 16, 0, 0); } while (0)

constexpr float WSCALE = 32.0f;
struct Bg { const float* wg; const float* wu; const float* wd; unsigned char* btgu; unsigned char* btd; int it, end; bool have; f32x4 r[8]; };
__device__ __forceinline__ void bg_decode(const Bg& B, int it, int lane, const float*& src, int& N, unsigned char*& dst, int& K) {
    const int me = it >> 10, r = it & 1023, e = me / 3, w = me - 3 * e, n4 = lane & 7, kr = lane >> 3;
    if (w == 2) { N = DM; K = FF; const int kb = r >> 6, nb = r & 63, nn = 32 * nb + 4 * n4, k0 = 64 * kb + 8 * kr; src = B.wd + (size_t)e * FF * DM + (size_t)k0 * DM + nn; dst = B.btd + (size_t)e * DM * FF + (size_t)nn * FF + k0; }
    else { N = FF; K = DM; const int kb = r >> 5, nb = r & 31, nn = 32 * nb + 4 * n4, k0 = 64 * kb + 8 * kr; src = (w == 0 ? B.wg : B.wu) + (size_t)e * DM * FF + (size_t)k0 * FF + nn;
           dst = B.btgu + (size_t)e * 2048 * DM + (size_t)(8 * (nn >> 2) + 4 * w) * DM + k0; }
}
__device__ __forceinline__ void bg_issue(Bg& B, int lane) {
    if (BG_MODE != 0 && B.it < B.end) { const float* src; unsigned char* dst; int N, K; bg_decode(B, B.it, lane, src, N, dst, K);
#pragma unroll
        for (int j = 0; j < 8; ++j) B.r[j] = __builtin_nontemporal_load((const f32x4*)(src + (size_t)j * N));
        B.have = true; ++B.it; }
}
__device__ __forceinline__ void bg_retire(Bg& B, int lane) {
    if (B.have) { const float* src; unsigned char* dst; int N, K; bg_decode(B, B.it - 1, lane, src, N, dst, K);
#pragma unroll
        for (int i = 0; i < 4; ++i) { v2u w; w.x = pk4_fp8(B.r[0][i] * WSCALE, B.r[1][i] * WSCALE, B.r[2][i] * WSCALE, B.r[3][i] * WSCALE); w.y = pk4_fp8(B.r[4][i] * WSCALE, B.r[5][i] * WSCALE, B.r[6][i] * WSCALE, B.r[7][i] * WSCALE);
            *(v2u*)(dst + (size_t)i * K) = w; }
        B.have = false; }
}

template <int MODE>
__device__ __forceinline__ void attn_unit(const Args& A, Bg& BG, int b, int h, int qb, LAS unsigned char* lds) {
    constexpr int NMAP = (MODE == 0) ? 2 : 1, NBUF = (MODE == 0) ? 2 : 3, QFOFF = (MODE == 0) ? QFOFF0 : QFOFF1, NGL = (MODE == 0) ? 4 : 3;
    int tid = threadIdx.x; asm volatile("" : "+v"(tid));
    const int lane = tid & 63, wid = __builtin_amdgcn_readfirstlane(tid >> 6);
    const int q0 = qb * 256, qw = q0 + wid * 32;
    const size_t rowbase = (size_t)b * SEQ;
    const int cq = (MODE == 0) ? C_DQ + h * 128 : C_RQ + h * 64;
    const int ck = (MODE == 0) ? C_DK + h * 128 : C_RK + h * 64;
    const int cv = (MODE == 0) ? C_DV + h * 128 : C_RV + h * 128;
    const int NT = (q0 + 256) / 64;
    const int ntw = (qw + 31) / 64 + 1;
    const char* pbase = (const char*)(A.proj + rowbase * NPROJ);
    const unsigned ldsw = (unsigned)wid * 1024u;
    LAS float* tbl = (LAS float*)(lds + TBOFF);
    { ATT_SRC(lane); ATT_STAGE(0, 0); if (NBUF == 3 && NT > 1) ATT_STAGE(1, BUFB); }
    if (MODE == 0) { if (tid < 304) tbl[tid] = A.tb[h * 304 + tid]; }
    { LAS unsigned char* qw_ = lds + QFOFF + wid * (NMAP * 4096) + lane * 16; const char* qg = pbase + (size_t)((qw + (lane & 31)) * NPROJ + cq + (lane >> 5) * 8) * 2;
#pragma unroll
      for (int f = 0; f < NMAP * 4; ++f) *(LAS v4u*)(qw_ + f * 1024) = *(const v4u*)(qg + (f >> 2) * 128 + (f & 3) * 32); }
    f32x16 o[NMAP][4];
#pragma unroll
    for (int c = 0; c < NMAP; ++c)
#pragma unroll
        for (int d = 0; d < 4; ++d)
#pragma unroll
            for (int r = 0; r < 16; ++r) o[c][d][r] = 0.f;
    float mref[NMAP], lsum[NMAP];
#pragma unroll
    for (int c = 0; c < NMAP; ++c) { mref[c] = -INFINITY; lsum[c] = 0.f; }
    float cg = 0.f;
    if (MODE == 1) { const double x = __builtin_ldexp(1.0, -5 - h); const double s = x * (1.0 + x * (0.5 + x * (1.0 / 3 + x * (0.25 + x * (0.2 + x * (1.0 / 6 + x * (1.0 / 7)))))));
        cg = (float)(-s * 1.4426950408889634); }
    VM_WAIT(); __syncthreads();
    for (int t = 0; t < NT; ++t) {
        const int bufo = (NBUF == 2 ? (t & 1) : (t % 3)) * BUFB, t0 = t * 64;
        int ln = lane; asm volatile("" : "+v"(ln));
        const bool staged = (t + NBUF - 1 < NT);
        if (staged) { ATT_SRC(ln); ATT_STAGE(t + NBUF - 1, ((t + NBUF - 1) % NBUF) * BUFB); }
        bool bg_now = false;
#define ATT_BGMID() do { bg_retire(BG, ln); const int ib_ = BG.it; if (MODE == 0 || (t % 3) == 0) bg_issue(BG, ln); bg_now = BG.it != ib_; } while (0)
        if (t >= ntw) ATT_BGMID();
        if (t < ntw) {
            const int r32 = ln & 31, hi = ln >> 5;
            const LAS unsigned char* kb = lds + bufo; const LAS unsigned char* vb = lds + bufo + VOFF;
            const bool near = (qw - t0) <= 175, diag = (t0 + 63) > qw;
            const int kbase = r32 * 128 + ((((r32 >> 2) & 3)) << 5) + ((hi ^ ((r32 >> 1) & 1)) << 4);
            int vbase;
            { const int i16 = ln & 15, q = i16 >> 2, p = i16 & 3, g = (ln >> 4) & 1; vbase = (4 * hi + q) * 256 + (((q << 2) + 2 * g + (p >> 1)) << 4) + 8 * (p & 1); }
            const LAS unsigned char* qlds = lds + QFOFF + wid * (NMAP * 4096) + ln * 16;
            LAS float* wsf = (LAS float*)(lds + WSFOFF) + wid * 64;
#pragma unroll
            for (int kh = 0; kh < 2; ++kh) {
              if (kh == 1) ATT_BGMID();
              if (t0 + 32 * kh > qw + 31) continue;
#pragma unroll
              for (int c = 0; c < NMAP; ++c) {
                f32x16 p;
                __builtin_amdgcn_sched_barrier(0);
                if (MODE == 0 && near) { const LAS float* tp = tbl + (207 - (qw + r32 - t0) + 4 * hi + 32 * kh);
#pragma unroll
                    for (int r = 0; r < 16; ++r) p[r] = tp[(r & 3) + 8 * (r >> 2)];
                } else { const float ini = (MODE == 0) ? tbl[0] : 0.f;
#pragma unroll
                    for (int r = 0; r < 16; ++r) p[r] = ini; }
#pragma unroll
                for (int s = 0; s < 4; ++s) {
                    const bf16x8 qf = *(const LAS bf16x8*)(qlds + (c * 4 + s) * 1024);
                    const bf16x8 kf = *(const LAS bf16x8*)(kb + c * KOFF1 + (kbase ^ (s << 5)) + kh * 4096);
                    p = __builtin_amdgcn_mfma_f32_32x32x16_bf16(kf, qf, p, 0, 0, 0);
                }
                const int qrel = qw + r32 - t0 - 4 * hi - 32 * kh;
                if (MODE == 0) {
                    if (diag) {
#pragma unroll
                        for (int r = 0; r < 16; ++r) { if ((r & 3) + 8 * (r >> 2) > qrel) p[r] = -INFINITY; } }
                    float rm = fmaxf(p[0], p[1]);
#pragma unroll
                    for (int r = 2; r < 16; ++r) rm = fmaxf(rm, p[r]);
                    { auto rr = __builtin_amdgcn_permlane32_swap(__float_as_uint(rm), __float_as_uint(rm), false, false); rm = fmaxf(__uint_as_float(rr[0]), __uint_as_float(rr[1])); }
                    if (__any(rm > mref[c] + THR)) {
                        const float mn = fmaxf(mref[c], rm); const float al = __builtin_amdgcn_exp2f(mref[c] - mn);
                        lsum[c] *= al; mref[c] = mn;
                        if (hi == 0) wsf[r32] = al;
                        LDS_WAIT();
#pragma unroll
                        for (int r = 0; r < 16; ++r) { const float a = wsf[crow(r, hi)];
#pragma unroll
                            for (int d = 0; d < 4; ++d) o[c][d][r] *= a; }
                        LDS_WAIT();
                    }
                    const float mm = mref[c]; float sacc = 0.f;
#pragma unroll
                    for (int r = 0; r < 16; ++r) { p[r] = __builtin_amdgcn_exp2f(p[r] - mm); sacc += p[r]; }
                    lsum[c] += sacc;
                } else {
                    const float rf = __builtin_amdgcn_exp2f(cg * (float)(qw + r32 - t0 - 32 * kh));
#pragma unroll
                    for (int r = 0; r < 16; ++r) { const float cf = __builtin_amdgcn_exp2f(-cg * (float)crow(r, hi)); p[r] = p[r] * (cf * rf); }
                    if (diag) {
#pragma unroll
                        for (int r = 0; r < 16; ++r) { if ((r & 3) + 8 * (r >> 2) > qrel) p[r] = 0.f; } }
                }
                v4u pa[2];
                pa[0] = (v4u){cvt_pk_bf16(p[0], p[1]), cvt_pk_bf16(p[2], p[3]), cvt_pk_bf16(p[4], p[5]), cvt_pk_bf16(p[6], p[7])};
                pa[1] = (v4u){cvt_pk_bf16(p[8], p[9]), cvt_pk_bf16(p[10], p[11]), cvt_pk_bf16(p[12], p[13]), cvt_pk_bf16(p[14], p[15])};
                { s16x4 va[4], vbq[4];
                  const int vad0 = (int)(uintptr_t)vb + (vbase ^ (0 << 6)) + kh * 8192, vad1 = (int)(uintptr_t)vb + (vbase ^ (1 << 6)) + kh * 8192;
                  const int vad2 = (int)(uintptr_t)vb + (vbase ^ (2 << 6)) + kh * 8192, vad3 = (int)(uintptr_t)vb + (vbase ^ (3 << 6)) + kh * 8192;
#define ATT_VRD(dst, ad) do { asm volatile("ds_read_b64_tr_b16 %0, %1" : "=v"(dst[0]) : "v"(ad) : "memory"); asm volatile("ds_read_b64_tr_b16 %0, %1 offset:2048" : "=v"(dst[1]) : "v"(ad) : "memory"); \
                                   asm volatile("ds_read_b64_tr_b16 %0, %1 offset:4096" : "=v"(dst[2]) : "v"(ad) : "memory"); asm volatile("ds_read_b64_tr_b16 %0, %1 offset:6144" : "=v"(dst[3]) : "v"(ad) : "memory"); } while (0)
#define ATT_VWAIT() do { asm volatile("s_waitcnt lgkmcnt(0)" ::: "memory"); __builtin_amdgcn_sched_barrier(0); } while (0)
#define ATT_PV(d, vv) do { o[c][d] = __builtin_amdgcn_mfma_f32_32x32x16_bf16(__builtin_bit_cast(bf16x8, pa[0]), ((bf16x8){vv[0][0], vv[0][1], vv[0][2], vv[0][3], vv[1][0], vv[1][1], vv[1][2], vv[1][3]}), o[c][d], 0, 0, 0); \
                                o[c][d] = __builtin_amdgcn_mfma_f32_32x32x16_bf16(__builtin_bit_cast(bf16x8, pa[1]), ((bf16x8){vv[2][0], vv[2][1], vv[2][2], vv[2][3], vv[3][0], vv[3][1], vv[3][2], vv[3][3]}), o[c][d], 0, 0, 0); } while (0)
                  __builtin_amdgcn_sched_barrier(0);
                  ATT_VRD(va, vad0); ATT_VWAIT();
                  ATT_VRD(vbq, vad1); __builtin_amdgcn_sched_barrier(0); ATT_PV(0, va); __builtin_amdgcn_sched_barrier(0); ATT_VWAIT();
                  ATT_VRD(va, vad2); __builtin_amdgcn_sched_barrier(0); ATT_PV(1, vbq); __builtin_amdgcn_sched_barrier(0); ATT_VWAIT();
                  ATT_VRD(vbq, vad3); __builtin_amdgcn_sched_barrier(0); ATT_PV(2, va); __builtin_amdgcn_sched_barrier(0); ATT_VWAIT();
                  ATT_PV(3, vbq); __builtin_amdgcn_sched_barrier(0);
#undef ATT_VRD
#undef ATT_VWAIT
#undef ATT_PV
                }
              }
            }
        }
        if (NBUF == 3 && staged) { if (bg_now) asm volatile("s_waitcnt vmcnt(11)" ::: "memory"); else asm volatile("s_waitcnt vmcnt(3)" ::: "memory"); }
        else { if (bg_now) asm volatile("s_waitcnt vmcnt(8)" ::: "memory"); else VM_WAIT(); }
#undef ATT_BGMID
        __syncthreads();
    }
    int lane_e = lane; asm volatile("" : "+v"(lane_e));
    LAS float* stg = (LAS float*)(lds + wid * STG_WAVE);
    { const int r32 = lane_e & 31, hi = lane_e >> 5;
      if (MODE == 0) {
        LAS float* wsf2 = (LAS float*)(lds + 8 * STG_WAVE) + wid * 64;
        float l0 = lsum[0], l1 = lsum[NMAP - 1];
        { auto rr = __builtin_amdgcn_permlane32_swap(__float_as_uint(l0), __float_as_uint(l0), false, false); l0 = __uint_as_float(rr[0]) + __uint_as_float(rr[1]); }
        { auto rr = __builtin_amdgcn_permlane32_swap(__float_as_uint(l1), __float_as_uint(l1), false, false); l1 = __uint_as_float(rr[0]) + __uint_as_float(rr[1]); }
        if (hi == 0) { wsf2[r32] = 1.0f / l0; wsf2[32 + r32] = -A.lam / l1; }
        LDS_WAIT();
#pragma unroll
        for (int r = 0; r < 16; ++r) { const float a0 = wsf2[crow(r, hi)], a1 = wsf2[32 + crow(r, hi)];
#pragma unroll
            for (int d = 0; d < 4; ++d) stg[crow(r, hi) * STG_PITCH + d * 32 + r32] = o[0][d][r] * a0 + o[NMAP - 1][d][r] * a1; }
      } else {
#pragma unroll
        for (int r = 0; r < 16; ++r)
#pragma unroll
            for (int d = 0; d < 4; ++d) stg[crow(r, hi) * STG_PITCH + d * 32 + r32] = o[0][d][r];
      }
    }
    LDS_WAIT();
    const int c8 = lane_e & 15;
#pragma unroll
    for (int ps = 0; ps < 8; ++ps) {
        const int row = 4 * ps + (lane_e >> 4);
        const f32x4 va = *(const LAS f32x4*)(stg + row * STG_PITCH + 8 * c8), vb4 = *(const LAS f32x4*)(stg + row * STG_PITCH + 8 * c8 + 4);
        float v[8] = {va[0], va[1], va[2], va[3], vb4[0], vb4[1], vb4[2], vb4[3]};
        const size_t tok = rowbase + qw + row;
        float ov[8];
        if (MODE == 0) {
            float ss = 0.f;
#pragma unroll
            for (int j = 0; j < 8; ++j) ss += v[j] * v[j];
            ss += __shfl_xor(ss, 1); ss += __shfl_xor(ss, 2); ss += __shfl_xor(ss, 4); ss += __shfl_xor(ss, 8);
            const float rn = 0.8f / sqrtf(ss * (1.0f / 128.0f) + EPS);
            const f32x4 g0 = *(const f32x4*)(A.subln_g + 8 * c8), g1 = *(const f32x4*)(A.subln_g + 8 * c8 + 4);
#pragma unroll
            for (int j = 0; j < 4; ++j) { ov[j] = v[j] * rn * g0[j]; ov[4 + j] = v[4 + j] * rn * g1[j]; }
        } else {
            float s1 = 0.f;
#pragma unroll
            for (int j = 0; j < 8; ++j) s1 += v[j];
            s1 += __shfl_xor(s1, 1); s1 += __shfl_xor(s1, 2); s1 += __shfl_xor(s1, 4); s1 += __shfl_xor(s1, 8);
            const float mu = s1 * (1.0f / 128.0f); float s2 = 0.f;
#pragma unroll
            for (int j = 0; j < 8; ++j) { v[j] -= mu; s2 += v[j] * v[j]; }
            s2 += __shfl_xor(s2, 1); s2 += __shfl_xor(s2, 2); s2 += __shfl_xor(s2, 4); s2 += __shfl_xor(s2, 8);
            const float rn = 1.0f / sqrtf(s2 * (1.0f / 128.0f) + EPS);
            const f32x4 g0 = *(const f32x4*)(A.gn_g + h * 128 + 8 * c8), g1 = *(const f32x4*)(A.gn_g + h * 128 + 8 * c8 + 4);
            const v4u gw = *(const v4u*)(A.proj + tok * NPROJ + C_RG + h * 128 + 8 * c8);
            float gt[8] = {bf2f(gw.x & 0xffff), bf2f(gw.x >> 16), bf2f(gw.y & 0xffff), bf2f(gw.y >> 16), bf2f(gw.z & 0xffff), bf2f(gw.z >> 16), bf2f(gw.w & 0xffff), bf2f(gw.w >> 16)};
#pragma unroll
            for (int j = 0; j < 8; ++j) { const float gg = (j < 4) ? g0[j] : g1[j - 4]; const float sl = gt[j] * __builtin_amdgcn_rcpf(1.0f + __builtin_amdgcn_exp2f(-gt[j] * LOG2E)); ov[j] = sl * (v[j] * rn * gg); }
        }
        v4u w; w.x = cvt_pk_bf16(ov[0], ov[1]); w.y = cvt_pk_bf16(ov[2], ov[3]); w.z = cvt_pk_bf16(ov[4], ov[5]); w.w = cvt_pk_bf16(ov[6], ov[7]);
        *(v4u*)(A.mix + tok * DM + (MODE == 0 ? 0 : 1024) + h * 128 + 8 * c8) = w;
    }
    LDS_WAIT(); __syncthreads();
}
#undef ATT_STAGE
#undef ATT_SRC
}

#define XB_TMO      128
#define XB_XCNT(j)  (256  + 64 * (j))
#define XB_XSUB(j)  (1280 + 64 * (j))
#define XB_XGEN(j)  (2304 + 64 * (j))
#define XB_TOP      3328
#define XB_TOPGEN   3392
#define XCD_BAR_WORDS 3456
#define XB_SPIN_CAP (1u << 18)
__device__ __forceinline__ unsigned xb_ld(unsigned* p)              { return __hip_atomic_load(p, __ATOMIC_RELAXED, __HIP_MEMORY_SCOPE_AGENT); }
__device__ __forceinline__ unsigned xb_add(unsigned* p, unsigned v) { return __hip_atomic_fetch_add(p, v, __ATOMIC_RELAXED, __HIP_MEMORY_SCOPE_AGENT); }
__device__ __forceinline__ unsigned xb_xcc_id() { return (unsigned)__builtin_amdgcn_s_getreg((3 << 11) | 20) & 0xFu; }
#define XB_SPIN(cond, bar) do { unsigned _sp = 0; while (cond) { __builtin_amdgcn_s_sleep(1); \
    if ((++_sp & 255u) == 0u) { if (xb_ld(&(bar)[XB_TMO])) break; if (_sp > XB_SPIN_CAP) { atomicAdd(&(bar)[XB_TMO], 1u); break; } } } } while (0)
struct XcdBarrier { unsigned* bar; unsigned x; volatile LAS unsigned* st; };
__device__ __forceinline__ XcdBarrier xcd_barrier_post(unsigned* bar, volatile LAS unsigned* st) {
    XcdBarrier b; b.bar = bar; b.x = xb_xcc_id(); b.st = st;
    if (threadIdx.x == 0) (void)xb_add(&bar[XB_XCNT(b.x)], 1u);
    return b;
}
__device__ __forceinline__ void xcd_barrier_complete(unsigned* bar, unsigned x, unsigned& nloc, unsigned& nx) {
    const unsigned G = gridDim.x * gridDim.y * gridDim.z;
    unsigned sum, cnt, mine, sp = 0u;
    for (;;) {
        sum = 0u; cnt = 0u; mine = 0u;
#pragma unroll
        for (unsigned j = 0; j < 16; ++j) { const unsigned c = xb_ld(&bar[XB_XCNT(j)]); sum += c; cnt += (c > 0u) ? 1u : 0u; mine = (j == x) ? c : mine; }
        if (sum == G) break;
        __builtin_amdgcn_s_sleep(1);
        if ((++sp & 255u) == 0u) { if (xb_ld(&bar[XB_TMO])) break; if (sp > XB_SPIN_CAP) { atomicAdd(&bar[XB_TMO], 1u); break; } }
    }
    nloc = mine > 0u ? mine : 1u; nx = cnt > 0u ? cnt : 1u;
}
__device__ __forceinline__ void xcd_barrier(const XcdBarrier& b) {
    asm volatile("s_waitcnt vmcnt(0)" ::: "memory");
    __syncthreads();
    if (threadIdx.x == 0) {
        unsigned* bar = b.bar;
        __builtin_amdgcn_s_waitcnt(0);
        unsigned nloc = b.st[0], nx = b.st[1];
        if (nloc == 0u) { xcd_barrier_complete(bar, b.x, nloc, nx); b.st[0] = nloc; b.st[1] = nx; }
        const unsigned old = xb_add(&bar[XB_XSUB(b.x)], 1u);
        const unsigned gen = old / nloc;
        if (old + 1u == (gen + 1u) * nloc) {
            __builtin_amdgcn_fence(__ATOMIC_RELEASE, "agent");
            asm volatile("s_waitcnt vmcnt(0)" ::: "memory");
            const unsigned og = xb_add(&bar[XB_TOP], 1u);
            const unsigned tg = og / nx;
            if (og + 1u == (tg + 1u) * nx) xb_add(&bar[XB_TOPGEN], 1u);
            else XB_SPIN(xb_ld(&bar[XB_TOPGEN]) == tg, bar);
            __builtin_amdgcn_fence(__ATOMIC_ACQUIRE, "agent");
            xb_add(&bar[XB_XGEN(b.x)], 1u);
            asm volatile("s_waitcnt vmcnt(0)" ::: "memory");
        } else {
            XB_SPIN(xb_ld(&bar[XB_XGEN(b.x)]) == gen, bar);
            __builtin_amdgcn_fence(__ATOMIC_ACQUIRE, "agent");
            asm volatile("s_waitcnt vmcnt(0)" ::: "memory");
        }
    }
    __syncthreads();
}

template <int MODE>
__device__ __forceinline__ int dest_row(int n) {
    if (MODE == 1) { if (n >= C_RQ && n < C_RV) { const int i = n & 63; return (n & ~63) + 2 * (i & 31) + (i >> 5); } return n; }
    if (MODE == 2) return 8 * (n >> 2) + (n & 3);
    if (MODE == 3) return 8 * (n >> 2) + 4 + (n & 3);
    return n;
}
template <int MODE>
__device__ __forceinline__ void p0_transpose_item(const float* W, int K, int N, bf16* WT, LAS float* scr, int item, int lane) {
    const int nblk = N / 32, kb = item / nblk, nb = item % nblk, k0 = 64 * kb, n0 = 32 * nb;
    float wv[32];
#pragma unroll
    for (int i = 0; i < 32; ++i) { const int kk = 2 * i + (lane >> 5); wv[i] = W[(size_t)(k0 + kk) * N + n0 + (lane & 31)]; }
#pragma unroll
    for (int i = 0; i < 32; ++i) { const int kk = 2 * i + (lane >> 5); scr[kk * 33 + (lane & 31)] = wv[i]; }
    LDS_WAIT(); asm volatile("" ::: "memory");
    const int c = lane & 7;
#pragma unroll
    for (int j = 0; j < 4; ++j) { const int n = (lane >> 3) + 8 * j; const LAS float* s = scr + (8 * c) * 33 + n;
        v4u o; o.x = pk2(s[0 * 33], s[1 * 33]); o.y = pk2(s[2 * 33], s[3 * 33]); o.z = pk2(s[4 * 33], s[5 * 33]); o.w = pk2(s[6 * 33], s[7 * 33]);
        *(GAS v4u*)(WT + (size_t)dest_row<MODE>(n0 + n) * K + k0 + 8 * c) = o; }
    LDS_WAIT(); asm volatile("" ::: "memory");
}

template <int MODE>
__device__ __forceinline__ void p0_direct_item(const float* W, int K, int N, bf16* WT, int item, int lane) {
    const int nblk = N / 32, kb = item / nblk, nb = item % nblk, n4 = lane & 7, kr = lane >> 3, k0 = 64 * kb + 8 * kr, n0 = 32 * nb + 4 * n4;
    const float* src = W + (size_t)k0 * N + n0;
    f32x4 r[8];
#pragma unroll
    for (int j = 0; j < 8; ++j) r[j] = *(const f32x4*)(src + (size_t)j * N);
#pragma unroll
    for (int i = 0; i < 4; ++i) { v4u w; w.x = pk2(r[0][i], r[1][i]); w.y = pk2(r[2][i], r[3][i]); w.z = pk2(r[4][i], r[5][i]); w.w = pk2(r[6][i], r[7][i]);
        *(GAS v4u*)(WT + (size_t)dest_row<MODE>(n0 + i) * K + k0) = w; }
}

struct KArgs { const float* in[20]; float* out; unsigned char* ws; int ph_lo, ph_hi; };

__global__ void __launch_bounds__(512, 2) hymba_fwd(KArgs args) {
    extern __shared__ __attribute__((aligned(16))) unsigned char lds_raw[];
    LAS unsigned char* lds = (LAS unsigned char*)lds_raw;
    volatile LAS unsigned* MISC = (volatile LAS unsigned*)(lds + MISC_OFF);
    LAS int* LTAB = (LAS int*)(lds + LTAB_OFF);
    const int tid = threadIdx.x, lane = tid & 63, wave = __builtin_amdgcn_readfirstlane(tid >> 6);
    const int G = gridDim.x; const int vcu = (G % 8 == 0) ? ((int)blockIdx.x % 8) * (G / 8) + (int)blockIdx.x / 8 : (int)blockIdx.x;
    const int gw = vcu * 8 + wave, NGW = G * 8;
    unsigned char* ws = args.ws;
    gu32* ctl = (gu32*)(ws + WS_CTL);
    const float* x = args.in[0]; const float* rel_bias = args.in[1]; const float* attn_norm_g = args.in[2]; const float* w_in = args.in[3];
    const float* lq1 = args.in[4]; const float* lk1 = args.in[5]; const float* lq2 = args.in[6]; const float* lk2 = args.in[7];
    const float* subln_g = args.in[8]; const float* gn_g = args.in[9]; const float* w_out = args.in[10]; const float* ffn_norm_g = args.in[11];
    const float* w_gr = args.in[12]; const float* b_group = args.in[13]; const float* w_ir = args.in[14]; const float* b_inner = args.in[15];
    const float* w_gate = args.in[16]; const float* w_up = args.in[17]; const float* w_down = args.in[18]; const float* final_g = args.in[19];
    float* out = args.out;
    f32x2* rope = (f32x2*)(ws + WS_ROPE); float* tbw = (float*)(ws + WS_TB);
    bf16* WRH = (bf16*)(ws + WS_WRH); bf16* WRL = (bf16*)(ws + WS_WRL);
    int* tok_e = (int*)(ws + WS_TOK + TOK_E); int* tok_rank = (int*)(ws + WS_TOK + TOK_RANK); float* irs1 = (float*)(ws + WS_TOK + TOK_GATE);
    float* tok_rs2 = (float*)(ws + WS_TOK + TOK_RS2); int* tok_pos = (int*)(ws + WS_TOK + TOK_POS); float* row_gate = (float*)(ws + WS_TOK + ROW_GATE);
    int* lst_tok = (int*)(ws + WS_LST); float* lst_rs = (float*)(ws + WS_LST + 2 * MiB); float* lst_gate = (float*)(ws + WS_LST + 4 * MiB);
    bf16* BTIN = (bf16*)(ws + WS_BTIN); bf16* BTOUT = (bf16*)(ws + WS_BTOUT); unsigned char* BTGU = ws + WS_BTGU; unsigned char* BTD = ws + WS_BTD;
    bf16* XN = (bf16*)(ws + WS_XN); bf16* MIX = (bf16*)(ws + WS_MIX); unsigned char* ACT = ws + WS_ACT;
    bf16* PROJ = (bf16*)(ws + WS_PROJ); unsigned char* XG = ws + WS_XG; unsigned char* Y = ws + WS_Y;
    bf16* X1 = (bf16*)(ws + WS_X1);

    for (int u = tid; u < (LDS_BYTES - LDSCTL_OFF) / 4; u += 512) ((LAS unsigned*)(lds + LDSCTL_OFF))[u] = 0u;
    __syncthreads();
    XcdBarrier bar; bar.bar = (unsigned*)(ctl + CW_BAR); bar.x = 0; bar.st = nullptr;
    if (N_LAUNCHES == 1) bar = xcd_barrier_post((unsigned*)(ctl + CW_BAR), MISC + 8);
    const int lo = args.ph_lo, hi_ph = args.ph_hi;
    long long tacc = 0, tdum = 0;
#if TPROBE == 7 || TPROBE == 9
    long long tprev = TP_T();
#endif
#if TPROBE == 10
    if (tid == 0) { const unsigned ts_ = (unsigned)__builtin_amdgcn_s_memrealtime(); __hip_atomic_fetch_max((unsigned*)(ctl + 32768), ts_, RLX_AGENT); __hip_atomic_fetch_max((unsigned*)(ctl + 32784), ~ts_, RLX_AGENT); }
#endif
#ifndef PHASE_MASK
#define PHASE_MASK 0x1ff
#endif
#define IN(k) (((PHASE_MASK >> (k)) & 1) && lo <= (k) && (k) < hi_ph)
#ifndef PROBE_DUP
#define PROBE_DUP 0
#endif
#define REP(k) ((((PROBE_DUP) >> (k)) & 1) ? 2 : 1)
#if TPROBE == 7
#define GRID_BAR(k) do { if (IN(k) && IN((k) + 1)) { xcd_barrier(bar); const long long tb_ = TP_T(); if ((k) == TPHASE) tacc += tb_ - tprev; tprev = tb_; } } while (0)
#elif TPROBE == 6
#define GRID_BAR(k) do { if (IN(k) && IN((k) + 1)) { const long long tb_ = TP_T(); xcd_barrier(bar); if ((k) == TPHASE) tacc += TP_T() - tb_; } } while (0)
#else
#define GRID_BAR(k) do { if (IN(k) && IN((k) + 1)) xcd_barrier(bar); } while (0)
#endif

    for (int rep_ = 0; rep_ < REP(0); ++rep_) if (IN(0)) {
        LAS float* scr = (LAS float*)(lds + RING_OFF + wave * 16384);
        constexpr int I_IN = (DM / 64) * (NPROJ / 32), I_OUT = (DM / 64) * (DM / 32);
        constexpr int NITEMS = I_IN + I_OUT;
        static_assert(BG_MODE == 3, "the expert weights are converted in the background of P2 only");
        for (int it = gw; it < NITEMS; it += NGW) {
            int r = it;
            if (r < I_IN) { p0_direct_item<1>(w_in, DM, NPROJ, BTIN, r, lane); continue; } r -= I_IN;
            p0_direct_item<0>(w_out, DM, DM, BTOUT, r, lane);
        }
        { const GAS f32x4* gr = (const GAS f32x4*)attn_norm_g + lane;
          f32x4 nx[8];
          if (gw < NTOK) { const GAS f32x4* xr = (const GAS f32x4*)(x + (size_t)gw * DM) + lane;
#pragma unroll
              for (int j = 0; j < 8; ++j) nx[j] = xr[64 * j]; }
          for (int m = gw; m < NTOK; m += NGW) {
            f32x4 v[8]; float s = 0.f;
#pragma unroll
            for (int j = 0; j < 8; ++j) { v[j] = nx[j]; s += (v[j].x * v[j].x + v[j].y * v[j].y) + (v[j].z * v[j].z + v[j].w * v[j].w); }
            if (m + NGW < NTOK) { const GAS f32x4* xr = (const GAS f32x4*)(x + (size_t)(m + NGW) * DM) + lane;
#pragma unroll
                for (int j = 0; j < 8; ++j) nx[j] = xr[64 * j]; }
            const float srt = sqrtf(wave_sum(s) * (1.0f / DM) + EPS), rs = 1.0f / srt;
            if (lane == 0) irs1[m] = srt;
            GAS unsigned long long* o8 = (GAS unsigned long long*)(XN + (size_t)m * DM) + lane;
#pragma unroll
            for (int j = 0; j < 8; ++j) { const f32x4 g = gr[64 * j]; o8[64 * j] = (unsigned long long)pk2(v[j].x * rs * g.x, v[j].y * rs * g.y) | ((unsigned long long)pk2(v[j].z * rs * g.z, v[j].w * rs * g.w) << 32); }
          }
        }
        for (int i = blockIdx.x * 512 + tid; i < SEQ * 32; i += G * 512) { const int pos = i >> 5, t = i & 31;
            const float f = __builtin_amdgcn_exp2f(-(float)t * (13.287712379549449f / 32.0f));
            double rev = (double)((float)pos * f) * 0.15915494309189535; rev -= __builtin_rint(rev);
            rope[i] = (f32x2){__builtin_amdgcn_cosf((float)rev), __builtin_amdgcn_sinf((float)rev)}; }
        for (int i = blockIdx.x * 512 + tid; i < 8 * 304; i += G * 512) { const int hh = i / 304, d = 207 - (i % 304); int bkt;
            if (d < 16) bkt = d < 0 ? 0 : d; else { const float lr = __logf((float)d / 16.0f) / 2.0794415416798357f; bkt = 16 + (int)(lr * 16.0f); bkt = bkt > 31 ? 31 : bkt; }
            tbw[i] = rel_bias[bkt * 8 + hh] * LOG2E; }
        for (int i = blockIdx.x * 512 + tid; i < 48 * DM; i += G * 512) { const int c = i / DM, k = i % DM; float w = 0.f;
            if (c < 4) w = w_gr[k * 4 + c]; else if (c < 36) { const int gq = (c - 4) >> 3, e = (c - 4) & 7; w = w_ir[((size_t)gq * DM + k) * 8 + e]; }
            const unsigned hb = f2bf(w); WRH[i] = (bf16)hb; WRL[i] = (bf16)f2bf(w - bf2f((unsigned short)hb)); }
    }
    GRID_BAR(0);

    if (IN(1)) {
        pg8::Gemm g{XN, BTIN, DM * 2, 0, nullptr}; pg8::StaticOrder S; S.init(NTOK, NPROJ, G, (int)blockIdx.x, REP(1));
        pg8::EpiProj E{PROJ, rope};
        pg8::gemm_phase<pg8::EpiProj, pg8::StaticOrder>(lds + RING_OFF, g, S, E, TPHASE == 1 ? tacc : tdum);
    }
    GRID_BAR(1);

    if (IN(2)) {
        float s1 = 0.f, s2 = 0.f;
        if (lane < 64) { s1 = lq1[lane] * lk1[lane]; s2 = lq2[lane] * lk2[lane]; }
        s1 = wave_sum(s1); s2 = wave_sum(s2);
        const float lam = __expf(s1) - __expf(s2) + 0.2f;
        att::Args A{PROJ, MIX, tbw, subln_g, gn_g, lam};
        att::Bg BG; BG.wg = w_gate; BG.wu = w_up; BG.wd = w_down; BG.btgu = BTGU; BG.btd = BTD; BG.have = false;
        { constexpr int NBG = NEXP * 3 * 1024; const int per = (NBG + NGW - 1) / NGW; BG.it = gw * per; BG.end = BG.it + per < NBG ? BG.it + per : NBG; if (BG.it > NBG) BG.it = NBG; }
#pragma unroll
        for (int j = 0; j < 8; ++j) BG.r[j] = (f32x4){0.f, 0.f, 0.f, 0.f};
        for (int it0 = vcu; it0 < 256 * REP(2); it0 += G) { const int it = it0 & 255;
            const int bh = it >> 2, s = it & 3, b = bh >> 3, h = bh & 7;
            for (int i = 0; i < 2; ++i) { const int qb = i ? s : 7 - s;
#ifndef NO_M0
                att::attn_unit<0>(A, BG, b, h, qb, lds);
#endif
#ifndef NO_M1
                att::attn_unit<1>(A, BG, b, h, qb, lds);
#endif
            }
        }
        for (;;) { att::bg_retire(BG, lane); if (BG.it >= BG.end) break; att::bg_issue(BG, lane); }
    }
    GRID_BAR(2);

    if (IN(3)) {
        pg8::Gemm g{MIX, BTOUT, DM * 2, 0, nullptr}; pg8::StaticOrder S; S.init(NTOK, DM, G, (int)blockIdx.x, REP(3));
        pg8::EpiRes E{XN, irs1, attn_norm_g, X1, XG, ffn_norm_g};
        pg8::gemm_phase<pg8::EpiRes, pg8::StaticOrder>(lds + RING_OFF, g, S, E, TPHASE == 3 ? tacc : tdum);
    }
    GRID_BAR(3);

    if (IN(4)) {
        LAS float* lgp = (LAS float*)(lds + RING_OFF) + (wave >> 1) * 1600;
        LAS unsigned char* wst = lds + RING_OFF + 25600;
        LAS float* gst = (LAS float*)(lds + RING_OFF + 25600 + 192 * 528);
        LAS int* bcnt = (LAS int*)(lds + LDSCTL_OFF + 4096);
        const int r = lane & 15, q4 = lane >> 4, kh = wave & 1;
        for (int i = tid; i < DM / 4; i += 512) ((LAS f32x4*)gst)[i] = ((const f32x4*)ffn_norm_g)[i];
        for (int tb = vcu; tb < NTOK / 64; tb += G) {
            const int t0 = tb * 64 + (wave >> 1) * 16;
            f32x4 acc[3]; float ss;
#if TPROBE == 12 || TPROBE == 14
            const long long tp4_ = TP_T();
#endif
            if (tid < 64) bcnt[tid] = 0;
            for (int rep4_ = 0; rep4_ < REP(4); ++rep4_) {
            acc[0] = (f32x4){0.f, 0.f, 0.f, 0.f}; acc[1] = acc[0]; acc[2] = acc[0]; ss = 0.f;
            const bf16* xrow = X1 + (size_t)(t0 + r) * DM + kh * 1024 + 8 * q4;
            unsigned char* xgrow = XG + (size_t)(t0 + r) * DM + kh * 1024 + 8 * q4;
            const LAS float* gl_ = gst + kh * 1024 + 8 * q4;
            const LAS unsigned char* wl_ = wst + ((kh * 2) * 48 + r) * 528 + q4 * 16;
            const int srow = tid >> 5, sch = tid & 31;
            v4u wq[12], xq[8], xn_[8];
#define P4_WLOAD(c_) do { _Pragma("unroll") for (int i = 0; i < 12; ++i) { const int sel_ = i / 3, row_ = (i % 3) * 16 + srow; \
                wq[i] = *(const v4u*)(((sel_ & 1) ? WRL : WRH) + (size_t)row_ * DM + (sel_ >> 1) * 1024 + (c_) * 256 + sch * 8); } } while (0)
            P4_WLOAD(0);
#pragma unroll
            for (int j = 0; j < 8; ++j) xn_[j] = *(const v4u*)(xrow + 32 * j);
#pragma unroll 1
            for (int c = 0; c < 4; ++c) { const int kb = c * 256;
                __syncthreads();
#pragma unroll
                for (int i = 0; i < 12; ++i) *(LAS v4u*)(wst + ((i / 3) * 48 + (i % 3) * 16 + srow) * 528 + sch * 16) = wq[i];
#pragma unroll
                for (int j = 0; j < 8; ++j) xq[j] = xn_[j];
                __syncthreads();
                if (c < 3) { P4_WLOAD(c + 1);
#pragma unroll
                    for (int j = 0; j < 8; ++j) xn_[j] = *(const v4u*)(xrow + kb + 256 + 32 * j); }
                v2u xgq[8];
#pragma unroll
                for (int j8 = 0; j8 < 8; ++j8) { const int k0 = kb + 32 * j8;
                    const v4u xw = xq[j8];
                    const f32x4 xa = (f32x4){bf2f(xw.x & 0xffff), bf2f(xw.x >> 16), bf2f(xw.y & 0xffff), bf2f(xw.y >> 16)}, xb = (f32x4){bf2f(xw.z & 0xffff), bf2f(xw.z >> 16), bf2f(xw.w & 0xffff), bf2f(xw.w >> 16)};
                    const f32x4 ga = *(const LAS f32x4*)(gl_ + k0), gb = *(const LAS f32x4*)(gl_ + k0 + 4);
                    float hv[8] = {xa[0] * ga[0], xa[1] * ga[1], xa[2] * ga[2], xa[3] * ga[3], xb[0] * gb[0], xb[1] * gb[1], xb[2] * gb[2], xb[3] * gb[3]};
                    ss += (xa[0] * xa[0] + xa[1] * xa[1]) + (xa[2] * xa[2] + xa[3] * xa[3]) + (xb[0] * xb[0] + xb[1] * xb[1]) + (xb[2] * xb[2] + xb[3] * xb[3]);
                    v4u ahw, alw;
#pragma unroll
                    for (int j = 0; j < 4; ++j) { const unsigned hw_ = cvt_pk_bf16(hv[2 * j], hv[2 * j + 1]); ahw[j] = hw_;
                        alw[j] = cvt_pk_bf16(hv[2 * j] - __builtin_bit_cast(float, hw_ << 16), hv[2 * j + 1] - __builtin_bit_cast(float, hw_ & 0xffff0000u)); }
                    xgq[j8].x = pk4_fp8(hv[0], hv[1], hv[2], hv[3]); xgq[j8].y = pk4_fp8(hv[4], hv[5], hv[6], hv[7]);
                    const bf16x8 ah = __builtin_bit_cast(bf16x8, ahw), al = __builtin_bit_cast(bf16x8, alw);
#pragma unroll
                    for (int cb = 0; cb < 3; ++cb) {
                        const bf16x8 bh = *(const LAS bf16x8*)(wl_ + cb * 16 * 528 + j8 * 64), bl = *(const LAS bf16x8*)(wl_ + (48 + cb * 16) * 528 + j8 * 64);
                        acc[cb] = __builtin_amdgcn_mfma_f32_16x16x32_bf16(ah, bh, acc[cb], 0, 0, 0);
                        acc[cb] = __builtin_amdgcn_mfma_f32_16x16x32_bf16(al, bh, acc[cb], 0, 0, 0);
                        acc[cb] = __builtin_amdgcn_mfma_f32_16x16x32_bf16(ah, bl, acc[cb], 0, 0, 0);
                    }
                }
#pragma unroll
                for (int j8 = 0; j8 < 8; ++j8) *(v2u*)(xgrow + kb + 32 * j8) = xgq[j8];
            }
#undef P4_WLOAD
            }
#if TPROBE == 12
            tacc += TP_T() - tp4_;
#endif
#if TPROBE == 13
            const long long tp4_ = TP_T();
#endif
            ss += __shfl_xor(ss, 16); ss += __shfl_xor(ss, 32);
            if (kh == 1) {
#pragma unroll
                for (int cb = 0; cb < 3; ++cb)
#pragma unroll
                    for (int i = 0; i < 4; ++i) lgp[768 + lane * 13 + cb * 4 + i] = acc[cb][i];
                lgp[768 + lane * 13 + 12] = ss;
            }
            __syncthreads();
            int e0 = 0, e1 = 0, lr0 = 0, lr1 = 0; float gt0 = 0.f, gt1 = 0.f, rs2 = 0.f;
            if (kh == 0) {
#pragma unroll
                for (int cb = 0; cb < 3; ++cb)
#pragma unroll
                    for (int i = 0; i < 4; ++i) lgp[(4 * q4 + i) * 48 + cb * 16 + r] = acc[cb][i] + lgp[768 + lane * 13 + cb * 4 + i];
                ss += lgp[768 + lane * 13 + 12];
                rs2 = 1.0f / sqrtf(ss * (1.0f / DM) + EPS);
                LDS_WAIT(); asm volatile("" ::: "memory");
                if (lane < 16) {
                    const LAS float* L = lgp + lane * 48;
                    float gl[4]; int gi = 0; float gmx = -INFINITY;
#pragma unroll
                    for (int g = 0; g < 4; ++g) { gl[g] = rs2 * L[g] + b_group[g]; if (gl[g] > gmx) { gmx = gl[g]; gi = g; } }
                    float den = 0.f;
#pragma unroll
                    for (int g = 0; g < 4; ++g) den += __expf(gl[g] - gmx);
                    const float pg = 1.0f / den;
                    int i0 = 0, i1 = 0; float v0 = -INFINITY, v1 = -INFINITY;
#pragma unroll
                    for (int e = 0; e < 8; ++e) { const float v = rs2 * L[4 + 8 * gi + e] + b_inner[gi * 8 + e]; if (v > v0) { v1 = v0; i1 = i0; v0 = v; i0 = e; } else if (v > v1) { v1 = v; i1 = e; } }
                    const float w0 = 1.0f / (1.0f + __expf(v1 - v0)), w1 = 1.0f - w0;
                    e0 = 8 * gi + i0; e1 = 8 * gi + i1; gt0 = pg * w0; gt1 = pg * w1;
                    lr0 = __hip_atomic_fetch_add(bcnt + e0, 1, __ATOMIC_RELAXED, __HIP_MEMORY_SCOPE_WORKGROUP);
                    lr1 = __hip_atomic_fetch_add(bcnt + e1, 1, __ATOMIC_RELAXED, __HIP_MEMORY_SCOPE_WORKGROUP);
                }
            }
            LDS_WAIT(); __syncthreads();
            if (tid < 32) { const int c = bcnt[tid]; bcnt[32 + tid] = c > 0 ? (int)__hip_atomic_fetch_add((unsigned*)(ctl + CW_CNT + 16 * tid), (unsigned)c, RLX_AGENT) : 0; }
            LDS_WAIT(); __syncthreads();
            if (kh == 0 && lane < 16) { const int tok = t0 + lane; const int rk0 = bcnt[32 + e0] + lr0, rk1 = bcnt[32 + e1] + lr1;
                tok_e[2 * tok] = e0; tok_e[2 * tok + 1] = e1; tok_rank[2 * tok] = rk0; tok_rank[2 * tok + 1] = rk1;
                lst_tok[e0 * pg8::LCAP + rk0] = tok; lst_rs[e0 * pg8::LCAP + rk0] = rs2; lst_gate[e0 * pg8::LCAP + rk0] = gt0;
                lst_tok[e1 * pg8::LCAP + rk1] = tok; lst_rs[e1 * pg8::LCAP + rk1] = rs2; lst_gate[e1 * pg8::LCAP + rk1] = gt1;
            }
            LDS_WAIT(); __syncthreads();
#if TPROBE == 13 || TPROBE == 14
            VM_WAIT(); tacc += TP_T() - tp4_;
#endif
        }
    }
    GRID_BAR(4);

    if (IN(6) || IN(7) || IN(8)) {
        if (tid == 0) { int off = 0, nt = 0;
            for (int e = 0; e < NEXP; ++e) { const int c = (int)__hip_atomic_load((unsigned*)(ctl + CW_CNT + 16 * e), RLX_AGENT); const int pc = (c + 255) >> 8;
                LTAB[e] = off; LTAB[96 + e] = c; for (int i = 0; i < pc; ++i) LTAB[128 + nt + i] = e; nt += pc; off += pc * 256; }
            LTAB[32] = nt; }
        __syncthreads();
    }
    {
        const int U = LTAB[32] * 8, R = U / G, rem = U - R * G, E = G - rem;
        const bool mixed = (FORCE_NOMIX == 0) && (N_LAUNCHES == 1) && IN(6) && IN(7) && R >= 1 && rem > 0 && 2 * rem <= G && (PROBE_DUP & 0xC0) == 0;
        const pg8::Gemm g6{XG, BTGU, DM, (size_t)2048 * DM, lst_tok}; const pg8::EpiSwiglu E6{ACT, lst_rs};
        const pg8::Gemm g7{ACT, BTD, FF, (size_t)DM * FF, nullptr}; const pg8::EpiDown E7{Y, lst_gate};
        if (mixed) {
            { pg8::GroupOrder S{LTAB[32], 8, G, vcu, LTAB, 0, R * G}; pg8::gemm_phase<pg8::EpiSwiglu, pg8::GroupOrder, true, true, 122, 127>(lds + RING_OFF, g6, S, E6, TPHASE == 6 ? tacc : tdum); }
            xcd_barrier(bar);
            if (vcu < rem) { pg8::GroupOrder S{LTAB[32], 8, G, vcu, LTAB, R * G, U}; pg8::gemm_phase<pg8::EpiSwiglu, pg8::GroupOrder, true, true, 122, 127>(lds + RING_OFF, g6, S, E6, TPHASE == 6 ? tacc : tdum); }
            else { pg8::GroupOrder S{LTAB[32], 8, G, vcu, LTAB, -rem, E}; pg8::gemm_phase<pg8::EpiDown, pg8::GroupOrder, false, true, 122, 127>(lds + RING_OFF, g7, S, E7, TPHASE == 7 ? tacc : tdum); }
            xcd_barrier(bar);
            { pg8::GroupOrder S{LTAB[32], 8, G, vcu, LTAB, E, U}; pg8::gemm_phase<pg8::EpiDown, pg8::GroupOrder, false, true, 122, 127>(lds + RING_OFF, g7, S, E7, TPHASE == 7 ? tacc : tdum); }
        } else {
            for (int rep_ = 0; rep_ < REP(6); ++rep_) if (IN(6)) { pg8::GroupOrder S{LTAB[32], 8, G, vcu, LTAB, 0, U}; pg8::gemm_phase<pg8::EpiSwiglu, pg8::GroupOrder, true, true, 122, 127>(lds + RING_OFF, g6, S, E6, TPHASE == 6 ? tacc : tdum); }
            GRID_BAR(6);
            for (int rep_ = 0; rep_ < REP(7); ++rep_) if (IN(7)) { pg8::GroupOrder S{LTAB[32], 8, G, vcu, LTAB, 0, U}; pg8::gemm_phase<pg8::EpiDown, pg8::GroupOrder, false, true, 122, 127>(lds + RING_OFF, g7, S, E7, TPHASE == 7 ? tacc : tdum); }
        }
    }
    GRID_BAR(7);

    for (int rep_ = 0; rep_ < REP(8); ++rep_) if (IN(8)) {
        unsigned poison = (__hip_atomic_load(ctl + CW_BAR + XB_TMO, RLX_AGENT) != 0u);
        int myd0 = 0, myd1 = 0;
        { const int m = gw + lane * NGW; if (m < NTOK) { myd0 = LTAB[tok_e[2 * m]] + tok_rank[2 * m]; myd1 = LTAB[tok_e[2 * m + 1]] + tok_rank[2 * m + 1]; } }
        const GAS f32x4* gr = (const GAS f32x4*)final_g + lane;
        v2u xv[8]; unsigned ya[8], yc[8];
#define P8_LOAD(i_) do { const int m_ = gw + (i_) * NGW; const int d0_ = __shfl(myd0, (i_)), d1_ = __shfl(myd1, (i_)); \
            const GAS v2u* xr_ = (const GAS v2u*)(X1 + (size_t)m_ * DM) + lane; const GAS unsigned* y0_ = (const GAS unsigned*)(Y + (size_t)d0_ * DM) + lane; const GAS unsigned* y1_ = (const GAS unsigned*)(Y + (size_t)d1_ * DM) + lane; \
            _Pragma("unroll") for (int j = 0; j < 8; ++j) { xv[j] = xr_[64 * j]; ya[j] = y0_[64 * j]; yc[j] = y1_[64 * j]; } } while (0)
        if (gw < NTOK) P8_LOAD(0);
        for (int i = 0, m = gw; m < NTOK; m += NGW, ++i) {
            f32x4 v[8]; float s = 0.f;
#pragma unroll
            for (int j = 0; j < 8; ++j) { const int a = (int)ya[j], c = (int)yc[j]; constexpr float iy = 1.0f / YSCALE;
                v[j].x = bf2f(xv[j].x & 0xffff) + (__builtin_amdgcn_cvt_f32_fp8(a, 0) + __builtin_amdgcn_cvt_f32_fp8(c, 0)) * iy; v[j].y = bf2f(xv[j].x >> 16) + (__builtin_amdgcn_cvt_f32_fp8(a, 1) + __builtin_amdgcn_cvt_f32_fp8(c, 1)) * iy;
                v[j].z = bf2f(xv[j].y & 0xffff) + (__builtin_amdgcn_cvt_f32_fp8(a, 2) + __builtin_amdgcn_cvt_f32_fp8(c, 2)) * iy; v[j].w = bf2f(xv[j].y >> 16) + (__builtin_amdgcn_cvt_f32_fp8(a, 3) + __builtin_amdgcn_cvt_f32_fp8(c, 3)) * iy;
                s += (v[j].x * v[j].x + v[j].y * v[j].y) + (v[j].z * v[j].z + v[j].w * v[j].w); }
            if (m + NGW < NTOK) P8_LOAD(i + 1);
            float rs = 1.0f / sqrtf(wave_sum(s) * (1.0f / DM) + EPS);
            if (poison) rs = __builtin_nanf("");
            GAS f32x4* orow = (GAS f32x4*)(out + (size_t)m * DM) + lane;
#pragma unroll
            for (int j = 0; j < 8; ++j) { const f32x4 g = gr[64 * j]; orow[64 * j] = (f32x4){v[j].x * rs * g.x, v[j].y * rs * g.y, v[j].z * rs * g.z, v[j].w * rs * g.w}; }
        }
#undef P8_LOAD
    }
#if TPROBE == 7
    if (TPHASE == 8) tacc += TP_T() - tprev;
#endif
#if TPROBE == 9
    tacc += TP_T() - tprev;
#endif
#if TPROBE == 10
    tacc = (long long)(__hip_atomic_load((unsigned*)(ctl + 32768), RLX_AGENT) - ~__hip_atomic_load((unsigned*)(ctl + 32784), RLX_AGENT));
#endif
#if TPROBE == 11
    { __syncthreads(); if (tid == 0) { const unsigned ts_ = (unsigned)__builtin_amdgcn_s_memrealtime(); __hip_atomic_fetch_max((unsigned*)(ctl + 32768), ts_, RLX_AGENT); __hip_atomic_fetch_max((unsigned*)(ctl + 32784), ~ts_, RLX_AGENT); }
      __syncthreads(); xcd_barrier(bar);
      tacc = (long long)(__hip_atomic_load((unsigned*)(ctl + 32768), RLX_AGENT) - ~__hip_atomic_load((unsigned*)(ctl + 32784), RLX_AGENT)); }
#endif
#if TPROBE
    if (blockIdx.x == TBLK && tid < 64) { const long long t0_ = (long long)__builtin_amdgcn_s_memrealtime(), d_ = tacc * TAMP; while ((long long)__builtin_amdgcn_s_memrealtime() - t0_ < d_) __builtin_amdgcn_s_sleep(8); }
#endif
#undef IN
#undef GRID_BAR
}

extern "C" void kernel_launch(void* const* d_in, const int* in_sizes, int n_in, void* d_out, int out_size, void* d_ws, size_t ws_size, hipStream_t stream) {
    static int grid = 0;
    if (grid == 0) {
        if (n_in != 20 || in_sizes[0] != NTOK * DM || out_size != NTOK * DM || ws_size < WS_END) {
            fprintf(stderr, "kernel_launch: unexpected shapes: n_in %d in0 %d out %d ws %zu (need %zu); nothing launched\n", n_in, n_in > 0 ? in_sizes[0] : -1, out_size, ws_size, (size_t)WS_END); grid = -1; return; }
        int dev = 0, cus = 0, per_cu = 0;
        if (hipGetDevice(&dev) != hipSuccess || hipDeviceGetAttribute(&cus, hipDeviceAttributeMultiprocessorCount, dev) != hipSuccess) { fprintf(stderr, "kernel_launch: device query failed\n"); grid = -1; return; }
        if (hipFuncSetAttribute((const void*)hymba_fwd, hipFuncAttributeMaxDynamicSharedMemorySize, LDS_BYTES) != hipSuccess) { fprintf(stderr, "kernel_launch: hipFuncSetAttribute failed\n"); grid = -1; return; }
        if (hipOccupancyMaxActiveBlocksPerMultiprocessor(&per_cu, (const void*)hymba_fwd, 512, LDS_BYTES) != hipSuccess || per_cu < 1) {
            fprintf(stderr, "kernel_launch: occupancy query reports %d workgroups per CU\n", per_cu); per_cu = 1; }
        (void)hipGetLastError();
        grid = cus;
    }
    if (grid < 0) return;
    if (hipMemsetAsync((char*)d_ws + WS_CTL, 0, CTL_ZERO_BYTES, stream) != hipSuccess) { fprintf(stderr, "kernel_launch: memset failed\n"); return; }
    KArgs a{};
    for (int i = 0; i < 20; ++i) a.in[i] = (const float*)d_in[i];
    a.out = (float*)d_out; a.ws = (unsigned char*)d_ws;
    for (int li = 0; li < N_LAUNCHES; ++li) {
        a.ph_lo = (N_LAUNCHES == 1) ? 0 : li; a.ph_hi = (N_LAUNCHES == 1) ? N_PHASES : li + 1;
        hipLaunchKernelGGL(hymba_fwd, dim3(grid), dim3(512), LDS_BYTES, stream, a);
        const hipError_t le = hipPeekAtLastError();
        if (le != hipSuccess) { fprintf(stderr, "kernel_launch: launch %d failed: %s\n", li, hipGetErrorName(le)); break; }
    }
}
```
